# Optimizing an MI355X kernel written in HIP

```python
import math
import jax, jax.numpy as jnp
from jax import lax
import numpy as np

D_MODEL = 2048
BATCH = 2
SEQ = 4096
DEPTH = 2

N_HEADS = 16
N_KV_HEADS = 4
HEAD_DIM = 64
ROT_DIM = HEAD_DIM // 4
ROPE_THETA = 500000.0
WINDOW = 128
BLOCK = 128
Q_WIDTH = N_HEADS * HEAD_DIM
KV_WIDTH = N_KV_HEADS * HEAD_DIM
D_CONV = D_MODEL // 2
CONV_K = 3
IN_COLS = Q_WIDTH + 2 * KV_WIDTH + 3 * D_CONV + 2 * D_MODEL
N_GROUPS = 4
EXPERTS_PER_GROUP = 8
N_EXPERTS = N_GROUPS * EXPERTS_PER_GROUP
TOP_K_IN_GROUP = 2
D_FF_EXPERT = 512
NORM_EPS = 1e-5

kernel_name = "hybrid_swa_shortconv_hiermoe"


def rmsnorm(x, g):
    xf = x.astype(jnp.float32)
    y = xf * lax.rsqrt(jnp.mean(xf * xf, axis=-1, keepdims=True) + NORM_EPS) * g.astype(jnp.float32)
    return y.astype(x.dtype)


def partial_rope(t, cos, sin):
    half = ROT_DIM // 2
    t1 = t[..., :half]
    t2 = t[..., half:ROT_DIM]
    c = cos[None, :, None, :]
    s = sin[None, :, None, :]
    return jnp.concatenate([t1 * c - t2 * s, t2 * c + t1 * s, t[..., ROT_DIM:]], axis=-1)


def sliding_window_attention(q, k, v, sinks):
    b, s, hq, dh = q.shape
    hkv = k.shape[2]
    grp = hq // hkv
    nb = s // BLOCK
    qb = q.reshape(b, nb, BLOCK, hkv, grp, dh)

    def with_prev(t):
        tb = t.reshape(b, nb, BLOCK, hkv, dh)
        prev = jnp.pad(tb, ((0, 0), (1, 0), (0, 0), (0, 0), (0, 0)))[:, :-1]
        return jnp.concatenate([prev, tb], axis=2)

    kk = with_prev(k)
    vv = with_prev(v)
    scores = jnp.einsum('bnqhgd,bnkhd->bnhgqk', qb, kk).astype(jnp.float32) * (1.0 / math.sqrt(dh))
    blk = jnp.arange(nb)[:, None] * BLOCK
    qpos = blk + jnp.arange(BLOCK)[None, :]
    kpos = blk - BLOCK + jnp.arange(2 * BLOCK)[None, :]
    diff = qpos[:, :, None] - kpos[:, None, :]
    mask = (diff >= 0) & (diff < WINDOW) & (kpos[:, None, :] >= 0)
    scores = jnp.where(mask[None, :, None, None], scores, -jnp.inf)
    sink_col = jnp.broadcast_to(sinks.astype(jnp.float32).reshape(1, 1, hkv, grp, 1, 1),
                                scores.shape[:-1] + (1,))
    probs = jax.nn.softmax(jnp.concatenate([scores, sink_col], axis=-1), axis=-1)[..., :-1]
    out = jnp.einsum('bnhgqk,bnkhd->bnqhgd', probs.astype(v.dtype), vv)
    return out.reshape(b, s, hq * dh)


def causal_short_conv(u, w):
    s = u.shape[1]
    kw = w.shape[0]
    up = jnp.pad(u, ((0, 0), (kw - 1, 0), (0, 0)))
    y = up[:, 0:s] * w[0]
    for j in range(1, kw):
        y = y + up[:, j:j + s] * w[j]
    return y


def hierarchical_moe(h, w_group, b_group, w_router, b_router, w_gate, w_up, w_down):
    b, s, d = h.shape
    n = b * s
    hf = h.reshape(n, d)
    g_logits = (hf @ w_group).astype(jnp.float32) + b_group.astype(jnp.float32)
    g_probs = jax.nn.softmax(g_logits, axis=-1)
    g_w, g_idx = lax.top_k(g_probs, 1)
    e_logits = ((hf @ w_router).astype(jnp.float32) + b_router.astype(jnp.float32)).reshape(n, N_GROUPS, EXPERTS_PER_GROUP)
    g_onehot = jax.nn.one_hot(g_idx[:, 0], N_GROUPS, dtype=jnp.float32)
    sel = jnp.einsum('ng,nge->ne', g_onehot, e_logits)
    e_probs = jax.nn.softmax(sel, axis=-1)
    e_w, e_idx = lax.top_k(e_probs, TOP_K_IN_GROUP)
    e_w = e_w / jnp.sum(e_w, axis=-1, keepdims=True)
    weights = g_w * e_w
    expert_id = g_idx * EXPERTS_PER_GROUP + e_idx
    combine = jnp.sum(jax.nn.one_hot(expert_id, N_EXPERTS, dtype=jnp.float32) * weights[..., None], axis=1)
    gate = jnp.einsum('nd,edf->enf', hf, w_gate)
    up = jnp.einsum('nd,edf->enf', hf, w_up)
    act = jax.nn.silu(gate) * up * combine.T.astype(hf.dtype)[:, :, None]
    out = jnp.einsum('enf,efd->nd', act, w_down)
    return out.reshape(b, s, d)


def setup_inputs(seed: int = 0) -> dict:
    key = jax.random.key(seed)
    ks = jax.random.split(key, 17)

    def nrm(k, shape, scale):
        return jax.random.normal(k, shape, jnp.float32) * scale

    return {
        "x": nrm(ks[0], (BATCH, SEQ, D_MODEL), 1.0),
        "g_mix": 1.0 + nrm(ks[1], (DEPTH, D_MODEL), 0.02),
        "w_in": nrm(ks[2], (DEPTH, D_MODEL, IN_COLS), D_MODEL ** -0.5),
        "sinks": nrm(ks[3], (DEPTH, N_HEADS), 0.5),
        "w_attn_out": nrm(ks[4], (DEPTH, Q_WIDTH, D_MODEL), Q_WIDTH ** -0.5),
        "conv_w": nrm(ks[5], (DEPTH, CONV_K, D_CONV), CONV_K ** -0.5),
        "w_conv_out": nrm(ks[6], (DEPTH, D_CONV, D_MODEL), D_CONV ** -0.5),
        "w_o": nrm(ks[7], (DEPTH, D_MODEL, D_MODEL), D_MODEL ** -0.5),
        "g_ffn": 1.0 + nrm(ks[8], (DEPTH, D_MODEL), 0.02),
        "w_group": nrm(ks[9], (DEPTH, D_MODEL, N_GROUPS), D_MODEL ** -0.5),
        "b_group": nrm(ks[10], (DEPTH, N_GROUPS), 0.01),
        "w_router": nrm(ks[11], (DEPTH, D_MODEL, N_EXPERTS), D_MODEL ** -0.5),
        "b_router": nrm(ks[12], (DEPTH, N_EXPERTS), 0.01),
        "w_gate": nrm(ks[13], (DEPTH, N_EXPERTS, D_MODEL, D_FF_EXPERT), D_MODEL ** -0.5),
        "w_up": nrm(ks[14], (DEPTH, N_EXPERTS, D_MODEL, D_FF_EXPERT), D_MODEL ** -0.5),
        "w_down": nrm(ks[15], (DEPTH, N_EXPERTS, D_FF_EXPERT, D_MODEL), D_FF_EXPERT ** -0.5),
        "g_final": 1.0 + nrm(ks[16], (D_MODEL,), 0.02),
    }


def reference(x, g_mix, w_in, sinks, w_attn_out, conv_w, w_conv_out, w_o, g_ffn,
              w_group, b_group, w_router, b_router, w_gate, w_up, w_down, g_final):
    b, s, d = x.shape
    pos = jnp.arange(s, dtype=jnp.float32)
    inv_freq = ROPE_THETA ** (-jnp.arange(0, ROT_DIM, 2, dtype=jnp.float32) / ROT_DIM)
    ang = pos[:, None] * inv_freq[None, :]
    cos = jnp.cos(ang).astype(x.dtype)
    sin = jnp.sin(ang).astype(x.dtype)
    sizes = [Q_WIDTH, KV_WIDTH, KV_WIDTH, D_CONV, D_CONV, D_CONV, D_MODEL, D_MODEL]
    split_at = [int(v) for v in np.cumsum(sizes)[:-1]]

    for l in range(DEPTH):
        h = rmsnorm(x, g_mix[l])
        p = h @ w_in[l]
        q, k, v, cb, cc, cx, ga, gc = jnp.split(p, split_at, axis=-1)
        q = partial_rope(q.reshape(b, s, N_HEADS, HEAD_DIM), cos, sin)
        k = partial_rope(k.reshape(b, s, N_KV_HEADS, HEAD_DIM), cos, sin)
        v = v.reshape(b, s, N_KV_HEADS, HEAD_DIM)
        a = sliding_window_attention(q, k, v, sinks[l]) @ w_attn_out[l]
        c = (cb * causal_short_conv(cc * cx, conv_w[l])) @ w_conv_out[l]
        merged = jax.nn.sigmoid(ga) * a + jax.nn.sigmoid(gc) * c
        x = x + merged @ w_o[l]
        h2 = rmsnorm(x, g_ffn[l])
        x = x + hierarchical_moe(h2, w_group[l], b_group[l], w_router[l], b_router[l],
                                 w_gate[l], w_up[l], w_down[l])
    return rmsnorm(x, g_final)
```

```cpp
#include <hip/hip_runtime.h>
#include <cstdio>
#include <cstdint>

#ifndef MK_REPEAT
#define MK_REPEAT 0
#endif
#define REP(k, cond) _Pragma("unroll 1") for (int rep_ = 0; rep_ < 1 + ((((MK_REPEAT) >> (k)) & 1) && (cond) ? 1 : 0); ++rep_)
#ifndef MK_PH_END
#define MK_PH_END 17
#endif
#ifndef MK_N_LAUNCHES
#define MK_N_LAUNCHES 1
#endif

constexpr int D = 2048, SEQ = 4096, M = 8192, DEPTH = 2;
constexpr int INC = 8704;
constexpr int C_Q = 0, C_K = 1024, C_V = 1280, C_CB = 1536, C_CC = 2560, C_CX = 3584, C_GA = 4608, C_GC = 6656;
constexpr int NE = 32, FF = 512;
constexpr float NORM_EPS = 1e-5f;
constexpr int NPHASE = 1 + 8 * DEPTH;

constexpr size_t MiB = 1u << 20;
constexpr size_t WS_CTL = 0, CTL_ZERO_BYTES = 128 * 1024;
constexpr size_t WS_ROPE = 1 * MiB;
constexpr size_t WS_TOK = 2 * MiB;
constexpr size_t WS_WGT = 3 * MiB;
constexpr size_t WS_WL = 4 * MiB, WL_STRIDE = 243 * MiB;
constexpr size_t WL_IN = 0, WL_A = 34 * MiB, WL_C = 38 * MiB, WL_O = 42 * MiB, WL_GU = 50 * MiB, WL_D = 178 * MiB, WL_R = 242 * MiB;
constexpr size_t WR_LO_OFF = 48 * 2048 * 2;
constexpr size_t WS_XRES = 490 * MiB;
constexpr size_t WS_H = 554 * MiB;
constexpr size_t WS_P = 586 * MiB;
constexpr size_t WS_Y2 = WS_P;
constexpr size_t WS_AO = 722 * MiB, WS_CV = 738 * MiB;
constexpr size_t WS_PART = 754 * MiB;
constexpr size_t WS_RSL = 756 * MiB;
constexpr size_t WS_MG = 818 * MiB;
constexpr size_t WS_ACT = 850 * MiB;
constexpr size_t WS_END = 874 * MiB;
constexpr int CW_TMO = 0, CW_CODE = 1, CW_BAR = 4096, CW_CNT = 16384;

constexpr int RING_BYTES = 131072;
constexpr int LDSCTL_OFF = RING_BYTES;
constexpr int MISC_OFF = LDSCTL_OFF + 320;
constexpr int TILE_OFF = LDSCTL_OFF + 1024;
constexpr int GTAB_OFF = LDSCTL_OFF + 4096;
constexpr int LDS_BYTES = 147456;
constexpr int NWAVES = 8;

#define GAS __attribute__((address_space(1)))
#define LAS __attribute__((address_space(3)))
typedef unsigned short bf16;
typedef unsigned v4u __attribute__((ext_vector_type(4)));
typedef unsigned v2u __attribute__((ext_vector_type(2)));
typedef float f32x4 __attribute__((ext_vector_type(4)));
typedef float f32x16 __attribute__((ext_vector_type(16)));
typedef short bf16x8 __attribute__((ext_vector_type(8)));
typedef short s16x4 __attribute__((ext_vector_type(4)));
typedef GAS unsigned gu32;
#define RLX_AGENT __ATOMIC_RELAXED, __HIP_MEMORY_SCOPE_AGENT
#define LDS_WAIT() asm volatile("s_waitcnt lgkmcnt(0)" ::: "memory")
#define VM_WAIT() asm volatile("s_waitcnt vmcnt(0)" ::: "memory")

__device__ __forceinline__ unsigned f2bf(float f) { unsigned u = __builtin_bit_cast(unsigned, f); return (u + 0x7fffu + ((u >> 16) & 1u)) >> 16; }
__device__ __forceinline__ unsigned pk2i(float lo, float hi) { return f2bf(lo) | (f2bf(hi) << 16); }
typedef float f32x2_t __attribute__((ext_vector_type(2))); typedef __bf16 bf16x2_t __attribute__((ext_vector_type(2)));
__device__ __forceinline__ unsigned pk2(float lo, float hi) { const f32x2_t v = {lo, hi}; const bf16x2_t b = __builtin_convertvector(v, bf16x2_t); return __builtin_bit_cast(unsigned, b); }
__device__ __forceinline__ float bflo(unsigned w) { return __builtin_bit_cast(float, w << 16); }
__device__ __forceinline__ float bfhi(unsigned w) { return __builtin_bit_cast(float, w & 0xffff0000u); }
__device__ __forceinline__ float sigmoidf_(float v) { return __builtin_amdgcn_rcpf(1.0f + __expf(-v)); }

namespace pg8 {
#define PG8_LAS __attribute__((address_space(3)))
typedef unsigned short bf16_t;
constexpr int BM = 256, BK = 64, HALF = 128, HTB = HALF * BK * 2, STAGE_BYTES = 8 * HTB, NXCD = 8, WGM = 8;

__host__ __device__ __forceinline__ int lds_byte(int r, int c) { const int st = (r >> 4) * 2 + (c >> 5), rr = r & 15, cc = c & 31, ob = rr * 64 + cc * 2; return st * 1024 + (ob ^ (((ob >> 9) & 1) << 5)); }
__host__ __device__ __forceinline__ void stage_rc(int b, int& R, int& C) { const int st = b / 1024, sb = b % 1024, swz = sb ^ (((sb >> 9) & 1) << 5); R = (st >> 1) * 16 + swz / 64; C = (st & 1) * 32 + (swz % 64) / 2; }
__host__ __device__ __forceinline__ int perm32(int rho) { const int n = rho >> 4, i = rho & 15; return 8 * (i >> 2) + 4 * n + (i & 3); }

struct Unit { int pm, pn, aux; };

struct TileOrder {
    int nM, nN, nwg, G, c;
    __device__ void init(int Mr, int Nc, int G_, int c_) { nM = Mr / BM; nN = Nc / BM; nwg = nM * nN; G = G_; c = c_; }
    __device__ bool tile(int i, int& pm, int& pn) const {
        const long L = (long)i * G + c; if (L >= nwg) return false;
        int wgid = (int)L; { const int q = nwg / NXCD, r = nwg % NXCD, xcd = wgid % NXCD, off = wgid / NXCD; wgid = (xcd < r ? xcd * (q + 1) : r * (q + 1) + (xcd - r) * q) + off; }
        const int nig = WGM * nN, gid = wgid / nig, fm = gid * WGM, gsz = (nM - fm) < WGM ? (nM - fm) : WGM;
        pm = fm + ((wgid % nig) % gsz); pn = (wgid % nig) / gsz; return true;
    }
};

template <class Epi, class Sched, bool ALIGN_EPI, bool GATHER>
__device__ __forceinline__ void gemm_phase(PG8_LAS unsigned char* lds, const int K, const Sched& S, const Epi& E) {
    int tid_ = threadIdx.x; asm volatile("" : "+v"(tid_));
    const int tid = tid_, wid = __builtin_amdgcn_readfirstlane(tid >> 6), lane = tid & 63, wr = wid >> 2, wc = wid & 3, fr = lane & 15, fq = lane >> 4;
    const int nt = K / BK;
    unsigned voffA[2], voffB[2]; int RA[2]; unsigned CA[2];
#pragma unroll
    for (int i = 0; i < 2; ++i) { int R, C; stage_rc(tid * 16 + i * 8192, R, C); const int Rb = Epi::PERM ? ((R & ~31) + perm32(R & 31)) : R;
        voffA[i] = (unsigned)(R * K + C) * 2u; voffB[i] = (unsigned)(Rb * K + C) * 2u; RA[i] = R; CA[i] = (unsigned)C * 2u; }
    const size_t kstep = (size_t)(BK * 2);
    const size_t hstep = (size_t)HALF * K * 2;
    const unsigned ldsw = (unsigned)wid * 1024u;
    const int aoff = lds_byte(wr * 64 + fr, fq * 8), boff = lds_byte(wc * 32 + fr, fq * 8);
    unsigned gvo[2][2], ngvo[2][2];
#define PG8_SA(b, h) (((b) * 2 + (h)) * HTB)
#define PG8_SB(b, h) ((4 + (b) * 2 + (h)) * HTB)
#define PG8_STAGE2(bufoff, gbase, v0, v1) do { \
        __builtin_amdgcn_global_load_lds((const unsigned*)((const char*)(gbase) + (v0)), (PG8_LAS unsigned*)(lds + (bufoff) + ldsw), 16, 0, 0); \
        __builtin_amdgcn_global_load_lds((const unsigned*)((const char*)(gbase) + (v1)), (PG8_LAS unsigned*)(lds + (bufoff) + ldsw + 8192), 16, 0, 0); } while (0)
#define PG8_STAGE_B(bufoff, gbase) PG8_STAGE2(bufoff, gbase, voffB[0], voffB[1])
#define PG8_STAGE_A(bufoff, kbase, h, nx) do { if constexpr (GATHER) { const unsigned _v0 = (nx) ? ngvo[h][0] : gvo[h][0], _v1 = (nx) ? ngvo[h][1] : gvo[h][1]; PG8_STAGE2(bufoff, kbase, _v0, _v1); } \
        else { PG8_STAGE2(bufoff, (kbase) + (h) * hstep, voffA[0], voffA[1]); } } while (0)
#define PG8_LDA(dst, b, h) do { _Pragma("unroll") for (int m = 0; m < 4; ++m) _Pragma("unroll") for (int k = 0; k < 2; ++k) dst[m][k] = *(const PG8_LAS bf16x8*)(lds + PG8_SA(b, h) + aoff + m * 2048 + k * 1024); } while (0)
#define PG8_LDB(dst, b, h) do { _Pragma("unroll") for (int n = 0; n < 2; ++n) _Pragma("unroll") for (int k = 0; k < 2; ++k) dst[n][k] = *(const PG8_LAS bf16x8*)(lds + PG8_SB(b, h) + boff + n * 2048 + k * 1024); } while (0)
#define PG8_MMA(ai, bj, At, Bt) do { __builtin_amdgcn_s_setprio(1); _Pragma("unroll") for (int m = 0; m < 4; ++m) _Pragma("unroll") for (int n = 0; n < 2; ++n) _Pragma("unroll") for (int k = 0; k < 2; ++k) \
        acc[ai][bj][m][n] = __builtin_amdgcn_mfma_f32_16x16x32_bf16(Bt[n][k], At[m][k], acc[ai][bj][m][n], 0, 0, 0); __builtin_amdgcn_s_setprio(0); } while (0)
#define PG8_WAIT_V(n) asm volatile("s_waitcnt vmcnt(" #n ")" ::: "memory")
#define PG8_WAIT_L(n) asm volatile("s_waitcnt lgkmcnt(" #n ")" ::: "memory")
#define PG8_BAR __builtin_amdgcn_s_barrier()
#define PG8_SCHED __builtin_amdgcn_sched_barrier(0)
    Unit cur, nxt; int ui = 0;
    if (!S.next(0, cur)) return;
    f32x4 acc[2][2][4][2];
    E.init(acc, cur, wr, wc, fr, fq);
    bf16x8 At[4][2], B0[2][2], B1[2][2];
    const char* cA = S.abase(cur); const char* cB = S.bbase(cur);
    if constexpr (GATHER) {
#pragma unroll
        for (int h = 0; h < 2; ++h)
#pragma unroll
            for (int i = 0; i < 2; ++i) { gvo[h][i] = S.goff(0, h * HALF + RA[i]) + CA[i]; ngvo[h][i] = gvo[h][i]; }
    }
    PG8_STAGE_B(PG8_SB(0, 0), cB); PG8_STAGE_B(PG8_SB(0, 1), cB + hstep); PG8_STAGE_A(PG8_SA(0, 0), cA, 0, false); PG8_STAGE_A(PG8_SA(0, 1), cA, 1, false);
    if (wr == 1) PG8_BAR;
    PG8_WAIT_V(2); PG8_BAR;
    PG8_STAGE_B(PG8_SB(1, 0), cB + kstep); PG8_STAGE_A(PG8_SA(1, 0), cA + kstep, 0, false); PG8_STAGE_B(PG8_SB(1, 1), cB + hstep + kstep);
    PG8_WAIT_V(6); PG8_BAR;
    for (;;) {
        const bool has_next = S.next(ui + 1, nxt);
        const char* nA = has_next ? S.abase(nxt) : cA; const char* nB = has_next ? S.bbase(nxt) : cB;
        if constexpr (GATHER) {
            if (has_next) {
#pragma unroll
                for (int h = 0; h < 2; ++h)
#pragma unroll
                    for (int i = 0; i < 2; ++i) ngvo[h][i] = S.goff(ui + 1, h * HALF + RA[i]) + CA[i];
            }
        }
        for (int t = 0; t < nt; t += 2) {
            const bool last = (t == nt - 2);
            const char* a1 = cA + (size_t)(t + 1) * kstep;
            const char* a2 = last ? nA : cA + (size_t)(t + 2) * kstep; const char* b2 = last ? nB : cB + (size_t)(t + 2) * kstep;
            const char* a3 = a2 + kstep; const char* b3 = b2 + kstep;
            PG8_LDB(B0, 0, 0); PG8_LDB(B1, 0, 1); PG8_SCHED; PG8_LDA(At, 0, 0); PG8_STAGE_A(PG8_SA(1, 1), a1, 1, false);
            PG8_WAIT_V(8); PG8_WAIT_L(0); PG8_BAR; PG8_MMA(0, 0, At, B0); PG8_MMA(0, 1, At, B1); PG8_BAR; PG8_SCHED;
            PG8_LDA(At, 0, 1); PG8_STAGE_B(PG8_SB(0, 0), b2); PG8_STAGE_B(PG8_SB(0, 1), b2 + hstep); PG8_STAGE_A(PG8_SA(0, 0), a2, 0, last);
            PG8_WAIT_V(8); PG8_WAIT_L(0); PG8_BAR; PG8_MMA(1, 0, At, B0); PG8_MMA(1, 1, At, B1); PG8_BAR; PG8_SCHED;
            PG8_LDB(B0, 1, 0); PG8_LDB(B1, 1, 1); PG8_SCHED; PG8_LDA(At, 1, 0); PG8_STAGE_A(PG8_SA(0, 1), a2, 1, last);
            PG8_WAIT_V(8); PG8_WAIT_L(0); PG8_BAR; PG8_MMA(0, 0, At, B0); PG8_MMA(0, 1, At, B1); PG8_BAR; PG8_SCHED;
            PG8_LDA(At, 1, 1); PG8_STAGE_B(PG8_SB(1, 0), b3); PG8_STAGE_B(PG8_SB(1, 1), b3 + hstep); PG8_STAGE_A(PG8_SA(1, 0), a3, 0, last);
            PG8_WAIT_V(8); PG8_WAIT_L(0); PG8_BAR; PG8_MMA(1, 0, At, B0); PG8_MMA(1, 1, At, B1); PG8_BAR; PG8_SCHED;
        }
        if constexpr (ALIGN_EPI) { if (wr == 0) PG8_BAR; }
        E(acc, cur, wr, wc, fr, fq);
        if (!has_next) break;
        if (!E.keep_acc(cur)) E.init(acc, nxt, wr, wc, fr, fq);
        cur = nxt; cA = nA; cB = nB; ++ui;
        if constexpr (GATHER) {
#pragma unroll
            for (int h = 0; h < 2; ++h)
#pragma unroll
                for (int i = 0; i < 2; ++i) gvo[h][i] = ngvo[h][i];
        }
        if constexpr (ALIGN_EPI) { if (wr == 1) PG8_BAR; }
    }
    PG8_WAIT_V(0);
    if constexpr (!ALIGN_EPI) { if (wr == 0) PG8_BAR; }
    PG8_BAR;
#undef PG8_SA
#undef PG8_SB
#undef PG8_STAGE2
#undef PG8_STAGE_A
#undef PG8_STAGE_B
#undef PG8_LDA
#undef PG8_LDB
#undef PG8_MMA
#undef PG8_WAIT_V
#undef PG8_WAIT_L
#undef PG8_BAR
#undef PG8_SCHED
}
}

struct SchedPlain {
    pg8::TileOrder T; const char* A; const char* Bt; size_t tstep;
    __device__ __forceinline__ bool next(int i, pg8::Unit& u) const { u.aux = 0; return T.tile(i, u.pm, u.pn); }
    __device__ __forceinline__ const char* abase(const pg8::Unit& u) const { return A + (size_t)u.pm * tstep; }
    __device__ __forceinline__ const char* bbase(const pg8::Unit& u) const { return Bt + (size_t)u.pn * tstep; }
    __device__ __forceinline__ unsigned goff(int, int) const { return 0u; }
};
struct SchedPair {
    pg8::TileOrder T; const char* A0; const char* A1; const char* B0; const char* B1; size_t tstep;
    __device__ __forceinline__ bool next(int i, pg8::Unit& u) const { u.aux = i & 1; return T.tile(i >> 1, u.pm, u.pn); }
    __device__ __forceinline__ const char* abase(const pg8::Unit& u) const { return (u.aux ? A1 : A0) + (size_t)u.pm * tstep; }
    __device__ __forceinline__ const char* bbase(const pg8::Unit& u) const { return (u.aux ? B1 : B0) + (size_t)u.pn * tstep; }
    __device__ __forceinline__ unsigned goff(int, int) const { return 0u; }
};
struct SchedMoe {
    const LAS int* tile_e; const LAS int* tile_mt; const LAS unsigned* gtab; int ntiles, nN, G, c;
    const char* A; const char* Bt; size_t a_tstep, b_estep, b_tstep; bool gather;
    __device__ __forceinline__ bool next(int i, pg8::Unit& u) const {
        int tile, pn;
        if (nN == 4) { const int x = c & 7, j = c >> 3, th = (ntiles + 1) >> 1, t = i * (G >> 3) + j; if (t >= th) return false; tile = (x >> 2) * th + t; if (tile >= ntiles) return false; pn = x & 3; }
        else { const int L = i * G + c; if (L >= ntiles * nN) return false; tile = L / nN; pn = L - tile * nN; }
        u.pm = tile; u.pn = pn; u.aux = tile_e[tile] | (tile_mt[tile] << 8); return true; }
    __device__ __forceinline__ const char* abase(const pg8::Unit& u) const { return gather ? A : A + (size_t)u.pm * a_tstep; }
    __device__ __forceinline__ const char* bbase(const pg8::Unit& u) const { return Bt + (size_t)(u.aux & 255) * b_estep + (size_t)u.pn * b_tstep; }
    __device__ __forceinline__ unsigned goff(int ui, int row) const { return gtab[ui * 256 + row]; }
};

using pg8::Unit;
struct EpiInProj {
    static constexpr bool PERM = true;
    bf16* P; const float* rope;
    __device__ __forceinline__ bool keep_acc(const Unit&) const { return false; }
    __device__ __forceinline__ void init(f32x4 (&acc)[2][2][4][2], const Unit&, int, int, int, int) const {
#pragma unroll
        for (int a = 0; a < 2; ++a)
#pragma unroll
            for (int b = 0; b < 2; ++b)
#pragma unroll
                for (int m = 0; m < 4; ++m)
#pragma unroll
                    for (int n = 0; n < 2; ++n) acc[a][b][m][n] = (f32x4){0.f, 0.f, 0.f, 0.f};
    }
    __device__ __forceinline__ void operator()(f32x4 (&acc)[2][2][4][2], const Unit& u, int wr, int wc, int fr, int fq) const {
        const int row0 = u.pm * 256 + wr * 64 + fr, col0 = u.pn * 256 + wc * 32 + 8 * fq;
        const int kind = u.pn <= 3 ? 0 : (u.pn == 4 ? 1 : (u.pn < 18 ? 2 : 3));
        const bool do_rope = (kind <= 1) && ((wc & 1) == 0);
        const float sgn = fq == 0 ? -1.f : 1.f;
#pragma unroll
        for (int ai = 0; ai < 2; ++ai)
#pragma unroll
            for (int m = 0; m < 4; ++m) {
                const int row = row0 + ai * 128 + m * 16;
                bf16* rowp = P + (size_t)row * INC + col0;
                f32x4 c0 = {1.f, 1.f, 1.f, 1.f}, c1 = c0, s0 = {0.f, 0.f, 0.f, 0.f}, s1 = s0;
                if (do_rope) { const f32x4* rp = (const f32x4*)(rope + (size_t)(row & (SEQ - 1)) * 16); c0 = rp[0]; c1 = rp[1]; s0 = rp[2]; s1 = rp[3]; }
#pragma unroll
                for (int bj = 0; bj < 2; ++bj) {
                    f32x4 v0 = acc[ai][bj][m][0], v1 = acc[ai][bj][m][1];
                    if (do_rope) {
                        f32x4 p0, p1;
#pragma unroll
                        for (int e = 0; e < 4; ++e) { p0[e] = __shfl_xor(v0[e], 16); p1[e] = __shfl_xor(v1[e], 16); }
                        if (fq < 2) { v0 = v0 * c0 + p0 * s0 * sgn; v1 = v1 * c1 + p1 * s1 * sgn; }
                    }
                    if (kind == 0) { v0 = v0 * 0.125f; v1 = v1 * 0.125f; }
                    if (kind == 3) {
#pragma unroll
                        for (int e = 0; e < 4; ++e) { v0[e] = sigmoidf_(v0[e]); v1[e] = sigmoidf_(v1[e]); }
                    }
                    v4u w; w.x = pk2(v0[0], v0[1]); w.y = pk2(v0[2], v0[3]); w.z = pk2(v1[0], v1[1]); w.w = pk2(v1[2], v1[3]);
                    *(v4u*)(rowp + bj * 128) = w;
                }
            }
    }
};
struct EpiMerge {
    static constexpr bool PERM = true;
    const bf16* P; bf16* MG;
    __device__ __forceinline__ bool keep_acc(const Unit& u) const { return u.aux == 0; }
    __device__ __forceinline__ void init(f32x4 (&acc)[2][2][4][2], const Unit&, int, int, int, int) const {
#pragma unroll
        for (int a = 0; a < 2; ++a)
#pragma unroll
            for (int b = 0; b < 2; ++b)
#pragma unroll
                for (int m = 0; m < 4; ++m)
#pragma unroll
                    for (int n = 0; n < 2; ++n) acc[a][b][m][n] = (f32x4){0.f, 0.f, 0.f, 0.f};
    }
    __device__ __forceinline__ void operator()(f32x4 (&acc)[2][2][4][2], const Unit& u, int wr, int wc, int fr, int fq) const {
        const int row0 = u.pm * 256 + wr * 64 + fr, col0 = u.pn * 256 + wc * 32 + 8 * fq;
#pragma unroll
        for (int ai = 0; ai < 2; ++ai)
#pragma unroll
            for (int m = 0; m < 4; ++m) {
                const int row = row0 + ai * 128 + m * 16;
                const bf16* gp = P + (size_t)row * INC + col0;
                v4u gc[2], ga[2];
#pragma unroll
                for (int bj = 0; bj < 2; ++bj) { gc[bj] = *(const v4u*)(gp + C_GC + bj * 128); if (u.aux == 0) ga[bj] = *(const v4u*)(gp + C_GA + bj * 128); }
#pragma unroll
                for (int bj = 0; bj < 2; ++bj) {
                    float f2[8] = {bflo(gc[bj].x), bfhi(gc[bj].x), bflo(gc[bj].y), bfhi(gc[bj].y), bflo(gc[bj].z), bfhi(gc[bj].z), bflo(gc[bj].w), bfhi(gc[bj].w)};
#pragma unroll
                    for (int e = 0; e < 8; ++e) f2[e] = __builtin_fmaxf(f2[e], 1e-30f);
                    f32x4& v0 = acc[ai][bj][m][0]; f32x4& v1 = acc[ai][bj][m][1];
                    if (u.aux == 0) {
                        const float sa[8] = {bflo(ga[bj].x), bfhi(ga[bj].x), bflo(ga[bj].y), bfhi(ga[bj].y), bflo(ga[bj].z), bfhi(ga[bj].z), bflo(ga[bj].w), bfhi(ga[bj].w)};
#pragma unroll
                        for (int e = 0; e < 4; ++e) { v0[e] *= sa[e] * __builtin_amdgcn_rcpf(f2[e]); v1[e] *= sa[4 + e] * __builtin_amdgcn_rcpf(f2[4 + e]); }
                    } else {
#pragma unroll
                        for (int e = 0; e < 4; ++e) { v0[e] *= f2[e]; v1[e] *= f2[4 + e]; }
                        v4u w; w.x = pk2(v0[0], v0[1]); w.y = pk2(v0[2], v0[3]); w.z = pk2(v1[0], v1[1]); w.w = pk2(v1[2], v1[3]);
                        *(v4u*)(MG + (size_t)row * D + col0 + bj * 128) = w;
                    }
                }
            }
    }
};
struct EpiResHx {
    static constexpr bool PERM = true;
    const float* base; float* out; bf16* HX; const float* g; float* part;
    __device__ __forceinline__ bool keep_acc(const Unit&) const { return false; }
    __device__ __forceinline__ void init(f32x4 (&acc)[2][2][4][2], const Unit& u, int wr, int wc, int fr, int fq) const {
        const int row0 = u.pm * 256 + wr * 64 + fr, col0 = u.pn * 256 + wc * 32 + 8 * fq;
#pragma unroll
        for (int ai = 0; ai < 2; ++ai)
#pragma unroll
            for (int m = 0; m < 4; ++m) { const size_t off = (size_t)(row0 + ai * 128 + m * 16) * D + col0;
#pragma unroll
                for (int bj = 0; bj < 2; ++bj) { acc[ai][bj][m][0] = *(const f32x4*)(base + off + bj * 128); acc[ai][bj][m][1] = *(const f32x4*)(base + off + bj * 128 + 4); } }
    }
    __device__ __forceinline__ void operator()(f32x4 (&acc)[2][2][4][2], const Unit& u, int wr, int wc, int fr, int fq) const {
        const int row0 = u.pm * 256 + wr * 64 + fr, col0 = u.pn * 256 + wc * 32 + 8 * fq;
        f32x4 gv[2][2];
#pragma unroll
        for (int bj = 0; bj < 2; ++bj) { gv[bj][0] = *(const f32x4*)(g + col0 + bj * 128); gv[bj][1] = *(const f32x4*)(g + col0 + bj * 128 + 4); }
#pragma unroll
        for (int ai = 0; ai < 2; ++ai)
#pragma unroll
            for (int m = 0; m < 4; ++m) {
                const int row = row0 + ai * 128 + m * 16; const size_t off = (size_t)row * D + col0;
                float ssum = 0.f;
#pragma unroll
                for (int bj = 0; bj < 2; ++bj) {
                    const f32x4 v0 = acc[ai][bj][m][0], v1 = acc[ai][bj][m][1];
                    *(f32x4*)(out + off + bj * 128) = v0; *(f32x4*)(out + off + bj * 128 + 4) = v1;
                    ssum += (v0.x * v0.x + v0.y * v0.y) + (v0.z * v0.z + v0.w * v0.w) + (v1.x * v1.x + v1.y * v1.y) + (v1.z * v1.z + v1.w * v1.w);
                    const f32x4 h0 = v0 * gv[bj][0], h1 = v1 * gv[bj][1];
                    v4u w; w.x = pk2(h0.x, h0.y); w.y = pk2(h0.z, h0.w); w.z = pk2(h1.x, h1.y); w.w = pk2(h1.z, h1.w);
                    *(v4u*)(HX + off + bj * 128) = w;
                }
                ssum += __shfl_xor(ssum, 16); ssum += __shfl_xor(ssum, 32);
                if (fq == 0) part[(size_t)row * 32 + u.pn * 4 + wc] = ssum;
            }
    }
};
struct EpiMoeGU {
    static constexpr bool PERM = true;
    bf16* ACT; const float* wgt; const float* rsl; const LAS int* cnt;
    __device__ __forceinline__ bool keep_acc(const Unit&) const { return false; }
    __device__ __forceinline__ void init(f32x4 (&acc)[2][2][4][2], const Unit&, int, int, int, int) const {
#pragma unroll
        for (int a = 0; a < 2; ++a)
#pragma unroll
            for (int b = 0; b < 2; ++b)
#pragma unroll
                for (int m = 0; m < 4; ++m)
#pragma unroll
                    for (int n = 0; n < 2; ++n) acc[a][b][m][n] = (f32x4){0.f, 0.f, 0.f, 0.f};
    }
    __device__ __forceinline__ void operator()(f32x4 (&acc)[2][2][4][2], const Unit& u, int wr, int wc, int fr, int fq) const {
        const int e = u.aux & 255, mt = u.aux >> 8, n_e = cnt[e];
        const int f0 = u.pn * 128 + wc * 32 + 8 * fq;
        float wrow[2][4], rrow[2][4];
#pragma unroll
        for (int ai = 0; ai < 2; ++ai)
#pragma unroll
            for (int m = 0; m < 4; ++m) { const int pos = mt * 256 + ai * 128 + wr * 64 + m * 16 + fr; const bool ok = pos < n_e; wrow[ai][m] = ok ? wgt[(size_t)e * M + pos] : 0.f; rrow[ai][m] = ok ? rsl[(size_t)e * M + pos] : 0.f; }
#pragma unroll
        for (int ai = 0; ai < 2; ++ai)
#pragma unroll
            for (int m = 0; m < 4; ++m) {
                const int rl = ai * 128 + wr * 64 + m * 16 + fr;
                const float w = wrow[ai][m] * rrow[ai][m], rsd = rrow[ai][m];
                const f32x4 g0 = acc[ai][0][m][0] * rsd, g1 = acc[ai][0][m][1] * rsd, u0 = acc[ai][1][m][0], u1 = acc[ai][1][m][1];
                f32x4 a0, a1;
#pragma unroll
                for (int k = 0; k < 4; ++k) { a0[k] = g0[k] * sigmoidf_(g0[k]) * u0[k] * w; a1[k] = g1[k] * sigmoidf_(g1[k]) * u1[k] * w; }
                v4u o; o.x = pk2(a0[0], a0[1]); o.y = pk2(a0[2], a0[3]); o.z = pk2(a1[0], a1[1]); o.w = pk2(a1[2], a1[3]);
                *(v4u*)(ACT + (size_t)(u.pm * 256 + rl) * FF + f0) = o;
            }
    }
};
struct EpiMoeDown {
    static constexpr bool PERM = true;
    bf16* Y2; const int* tok; const LAS int* cnt;
    __device__ __forceinline__ bool keep_acc(const Unit&) const { return false; }
    __device__ __forceinline__ void init(f32x4 (&acc)[2][2][4][2], const Unit&, int, int, int, int) const {
#pragma unroll
        for (int a = 0; a < 2; ++a)
#pragma unroll
            for (int b = 0; b < 2; ++b)
#pragma unroll
                for (int m = 0; m < 4; ++m)
#pragma unroll
                    for (int n = 0; n < 2; ++n) acc[a][b][m][n] = (f32x4){0.f, 0.f, 0.f, 0.f};
    }
    __device__ __forceinline__ void operator()(f32x4 (&acc)[2][2][4][2], const Unit& u, int wr, int wc, int fr, int fq) const {
        const int e = u.aux & 255, mt = u.aux >> 8, n_e = cnt[e];
        const int col0 = u.pn * 256 + wc * 32 + 8 * fq;
        int trow[2][4];
#pragma unroll
        for (int ai = 0; ai < 2; ++ai)
#pragma unroll
            for (int m = 0; m < 4; ++m) { const int pos = mt * 256 + ai * 128 + wr * 64 + m * 16 + fr; trow[ai][m] = pos < n_e ? tok[(size_t)e * M + pos] : -1; }
#pragma unroll
        for (int ai = 0; ai < 2; ++ai)
#pragma unroll
            for (int m = 0; m < 4; ++m) {
                const int t = trow[ai][m];
                if (t >= 0) {
                    bf16* yp = Y2 + (size_t)t * D + col0;
#pragma unroll
                    for (int bj = 0; bj < 2; ++bj) { const f32x4 v0 = acc[ai][bj][m][0], v1 = acc[ai][bj][m][1];
                        v4u w; w.x = pk2(v0[0], v0[1]); w.y = pk2(v0[2], v0[3]); w.z = pk2(v1[0], v1[1]); w.w = pk2(v1[2], v1[3]);
                        *(v4u*)(yp + bj * 128) = w; }
                }
            }
    }
};

#define XB_TMO      128
#define XB_XCNT(j)  (256  + 64 * (j))
#define XB_XSUB(j)  (1280 + 64 * (j))
#define XB_XGEN(j)  (2304 + 64 * (j))
#define XB_TOP      3328
#define XB_TOPGEN   3392
#define XCD_BAR_WORDS 3456
#define XB_SPIN_CAP (1u << 18)

__device__ __forceinline__ unsigned xb_ld(unsigned* p)              { return __hip_atomic_load((gu32*)p, __ATOMIC_RELAXED, __HIP_MEMORY_SCOPE_AGENT); }
__device__ __forceinline__ unsigned xb_add(unsigned* p, unsigned v) { return __hip_atomic_fetch_add((gu32*)p, v, __ATOMIC_RELAXED, __HIP_MEMORY_SCOPE_AGENT); }
__device__ __forceinline__ unsigned xb_xcc_id() { return (unsigned)__builtin_amdgcn_s_getreg((3 << 11) | 20) & 0xFu; }
#define XB_SPIN(cond, bar) do { unsigned _sp = 0; while (cond) { __builtin_amdgcn_s_sleep(1); \
    if ((++_sp & 255u) == 0u) { if (xb_ld(&(bar)[XB_TMO])) break; if (_sp > XB_SPIN_CAP) { (void)xb_add(&(bar)[XB_TMO], 1u); break; } } } } while (0)

struct XcdBarrier {
    unsigned* bar; unsigned x;
    volatile LAS unsigned* st;
};
__device__ __forceinline__ XcdBarrier xcd_barrier_post(unsigned* bar, volatile LAS unsigned* st) {
    XcdBarrier b; b.bar = bar; b.x = xb_xcc_id(); b.st = st;
    if (threadIdx.x == 0) (void)xb_add(&bar[XB_XCNT(b.x)], 1u);
    return b;
}
__device__ __forceinline__ void xcd_barrier_complete(unsigned* bar, unsigned x, unsigned& nloc, unsigned& nx) {
    const unsigned G = gridDim.x * gridDim.y * gridDim.z;
    unsigned sum, cnt, mine, sp = 0u;
    for (;;) {
        sum = 0u; cnt = 0u; mine = 0u;
#pragma unroll
        for (unsigned j = 0; j < 16; ++j) { const unsigned c = xb_ld(&bar[XB_XCNT(j)]); sum += c; cnt += (c > 0u) ? 1u : 0u; mine = (j == x) ? c : mine; }
        if (sum == G) break;
        __builtin_amdgcn_s_sleep(1);
        if ((++sp & 255u) == 0u) { if (xb_ld(&bar[XB_TMO])) break; if (sp > XB_SPIN_CAP) { (void)xb_add(&bar[XB_TMO], 1u); break; } }
    }
    nloc = mine > 0u ? mine : 1u; nx = cnt > 0u ? cnt : 1u;
}
__device__ __forceinline__ void xcd_barrier(const XcdBarrier& b) {
    asm volatile("s_waitcnt vmcnt(0)" ::: "memory");
    __syncthreads();
    if (threadIdx.x == 0) {
        unsigned* bar = b.bar; unsigned bx_ = b.x;
        asm volatile("" : "+s"(bar), "+s"(bx_));
        __builtin_amdgcn_s_waitcnt(0);
        unsigned nloc = b.st[0], nx = b.st[1];
        if (nloc == 0u) { xcd_barrier_complete(bar, bx_, nloc, nx); b.st[0] = nloc; b.st[1] = nx; }
        const unsigned old = xb_add(&bar[XB_XSUB(bx_)], 1u);
        const unsigned gen = old / nloc;
        if (old + 1u == (gen + 1u) * nloc) {
            __builtin_amdgcn_fence(__ATOMIC_RELEASE, "agent");
            asm volatile("s_waitcnt vmcnt(0)" ::: "memory");
            const unsigned og = xb_add(&bar[XB_TOP], 1u);
            const unsigned tg = og / nx;
            if (og + 1u == (tg + 1u) * nx) xb_add(&bar[XB_TOPGEN], 1u);
            else XB_SPIN(xb_ld(&bar[XB_TOPGEN]) == tg, bar);
            __builtin_amdgcn_fence(__ATOMIC_ACQUIRE, "agent");
            xb_add(&bar[XB_XGEN(bx_)], 1u);
            asm volatile("s_waitcnt vmcnt(0)" ::: "memory");
        } else {
            XB_SPIN(xb_ld(&bar[XB_XGEN(bx_)]) == gen, bar);
            __builtin_amdgcn_fence(__ATOMIC_ACQUIRE, "agent");
            asm volatile("s_waitcnt vmcnt(0)" ::: "memory");
        }
    }
    __syncthreads();
}

__device__ __forceinline__ float wave_sum(float v) {
#pragma unroll
    for (int o = 1; o < 64; o <<= 1) v += __shfl_xor(v, o);
    return v;
}
struct Args { const float* in[17]; float* out; unsigned char* ws; int ph_lo, ph_hi, li, pad; };
struct CvtItem { const float* W; bf16* WT; int K, N, k0, n0, drow0; };
enum { CVT_WIN = 0, CVT_S = 1, CVT_GU = 2, CVT_B = 3 };
__device__ __forceinline__ int cvt_count(int list) { return list == CVT_WIN ? 64 * 136 : list == CVT_S ? (1024 + 1024 + 2048) : list == CVT_GU ? 2 * 16384 : 16384; }
__device__ __forceinline__ CvtItem cvt_decode(const Args& a, int list, int l, int it) {
    CvtItem c; unsigned char* wl = a.ws + WS_WL + (size_t)l * WL_STRIDE;
    if (list == CVT_WIN) { const int kb = it / 136, nb = it - kb * 136; c.W = a.in[2] + (size_t)l * D * INC; c.WT = (bf16*)(wl + WL_IN); c.K = D; c.N = INC; c.k0 = 32 * kb; c.n0 = 64 * nb; c.drow0 = c.n0; return c; }
    if (list == CVT_B) { const int e = it >> 9, q = it & 511, kb = q >> 5, nb = q & 31; c.W = a.in[15] + ((size_t)l * NE + e) * FF * D; c.WT = (bf16*)(wl + WL_D) + (size_t)e * D * FF; c.K = FF; c.N = D; c.k0 = 32 * kb; c.n0 = 64 * nb; c.drow0 = c.n0; return c; }
    int r = it;
    if (list == CVT_S) {
    if (r < 1024) { c.W = a.in[4] + (size_t)l * 1024 * D; c.WT = (bf16*)(wl + WL_A); c.K = 1024; c.N = D; c.k0 = 32 * (r >> 5); c.n0 = 64 * (r & 31); c.drow0 = c.n0; return c; } r -= 1024;
    if (r < 1024) { c.W = a.in[6] + (size_t)l * 1024 * D; c.WT = (bf16*)(wl + WL_C); c.K = 1024; c.N = D; c.k0 = 32 * (r >> 5); c.n0 = 64 * (r & 31); c.drow0 = c.n0; return c; } r -= 1024;
    { c.W = a.in[7] + (size_t)l * D * D; c.WT = (bf16*)(wl + WL_O); c.K = D; c.N = D; c.k0 = 32 * (r >> 5); c.n0 = 64 * (r & 31); c.drow0 = c.n0; return c; }
    }
    const int up = r >= 16384; if (up) r -= 16384;
    const int e = r >> 9, q = r & 511, kb = q >> 3, nb = q & 7;
    c.W = a.in[up ? 14 : 13] + ((size_t)l * NE + e) * D * FF; c.WT = (bf16*)(wl + WL_GU) + (size_t)e * 1024 * D; c.K = D; c.N = FF; c.k0 = 32 * kb; c.n0 = 64 * nb;
    c.drow0 = (c.n0 >> 7) * 256 + (c.n0 & 127) + (up ? 128 : 0); return c;
}
__device__ __forceinline__ void cvt_load(f32x4 (&v)[8], const CvtItem& c, int lane) {
    const float* p = c.W + (size_t)(c.k0 + (lane >> 4)) * c.N + c.n0 + (lane & 15) * 4;
#pragma unroll
    for (int i = 0; i < 8; ++i) v[i] = __builtin_nontemporal_load((const f32x4*)(p + (size_t)(4 * i) * c.N));
}
__device__ __forceinline__ void cvt_emit(const f32x4 (&v)[8], const CvtItem& cur, LAS float* scr, int lane) {
    const int lr = lane >> 4, lc = (lane & 15) * 4, c8 = (lane & 3) * 8, nr = lane >> 2;
#pragma unroll
    for (int i = 0; i < 8; ++i) { LAS float* d = scr + (4 * i + lr) * 65 + lc; d[0] = v[i].x; d[1] = v[i].y; d[2] = v[i].z; d[3] = v[i].w; }
    LDS_WAIT(); asm volatile("" ::: "memory");
#pragma unroll
    for (int jj = 0; jj < 4; ++jj) { const int n = nr + 16 * jj; const LAS float* s = scr + c8 * 65 + n;
        v4u o; o.x = pk2(s[0 * 65], s[1 * 65]); o.y = pk2(s[2 * 65], s[3 * 65]); o.z = pk2(s[4 * 65], s[5 * 65]); o.w = pk2(s[6 * 65], s[7 * 65]);
        __builtin_nontemporal_store(o, (GAS v4u*)(cur.WT + (size_t)(cur.drow0 + n) * cur.K + cur.k0 + c8)); }
    LDS_WAIT(); asm volatile("" ::: "memory");
}
__device__ __forceinline__ void cvt_run(const Args& a, int list, int l, int w, int nw, LAS float* scr, int lane, int it_lo = 0, int it_hi = 1 << 30) {
    const int T = cvt_count(list) < it_hi ? cvt_count(list) : it_hi;
    int it = it_lo + w;
    CvtItem cA, cB, cC; f32x4 vA[8], vB[8], vC[8];
    bool hA = it < T, hB, hC;
    if (hA) { cA = cvt_decode(a, list, l, it); cvt_load(vA, cA, lane); } it += nw;
    hB = it < T; if (hB) { cB = cvt_decode(a, list, l, it); cvt_load(vB, cB, lane); } it += nw;
    while (hA) {
        hC = it < T; if (hC) { cC = cvt_decode(a, list, l, it); cvt_load(vC, cC, lane); } it += nw;
        cvt_emit(vA, cA, scr, lane);
        if (!hB) break;
        hA = it < T; if (hA) { cA = cvt_decode(a, list, l, it); cvt_load(vA, cA, lane); } it += nw;
        cvt_emit(vB, cB, scr, lane);
        if (!hC) break;
        hB = it < T; if (hB) { cB = cvt_decode(a, list, l, it); cvt_load(vB, cB, lane); } it += nw;
        cvt_emit(vC, cC, scr, lane);
    }
}
__device__ __forceinline__ void norm_row(const float* xrow, const bf16* y0, const bf16* y1, float* xo, const float* g, bf16* hb, float* of, int lane) {
    f32x4 v[8]; float s = 0.f;
#pragma unroll
    for (int j = 0; j < 8; ++j) { v[j] = ((const f32x4*)xrow)[lane + 64 * j]; }
    if (y0) {
        v2u a0[8], a1[8];
#pragma unroll
        for (int j = 0; j < 8; ++j) { a0[j] = ((const v2u*)y0)[lane + 64 * j]; a1[j] = ((const v2u*)y1)[lane + 64 * j]; }
#pragma unroll
        for (int j = 0; j < 8; ++j) { v[j].x += bflo(a0[j].x); v[j].y += bfhi(a0[j].x); v[j].z += bflo(a0[j].y); v[j].w += bfhi(a0[j].y); }
#pragma unroll
        for (int j = 0; j < 8; ++j) { v[j].x += bflo(a1[j].x); v[j].y += bfhi(a1[j].x); v[j].z += bflo(a1[j].y); v[j].w += bfhi(a1[j].y); }
    }
#pragma unroll
    for (int j = 0; j < 8; ++j) s += (v[j].x * v[j].x + v[j].y * v[j].y) + (v[j].z * v[j].z + v[j].w * v[j].w);
    if (xo) {
#pragma unroll
        for (int j = 0; j < 8; ++j) ((f32x4*)xo)[lane + 64 * j] = v[j];
    }
    const float rstd = 1.0f / sqrtf(wave_sum(s) * (1.f / D) + NORM_EPS);
#pragma unroll
    for (int j = 0; j < 8; ++j) {
        const f32x4 gg = ((const f32x4*)g)[lane + 64 * j];
        const f32x4 o = v[j] * rstd * gg;
        if (hb) { v2u w; w.x = pk2(o.x, o.y); w.y = pk2(o.z, o.w); ((v2u*)hb)[lane + 64 * j] = w; }
        else ((f32x4*)of)[lane + 64 * j] = o;
    }
}


__device__ __forceinline__ void phase_prologue(const Args& a, LAS unsigned char* lds, int vcu, int G, int wave, int lane) {
    unsigned char* ws = a.ws;
    LAS float* scr = (LAS float*)(lds + wave * 16384);
    const int gw = vcu * NWAVES + wave, NGW = G * NWAVES;
    cvt_run(a, CVT_WIN, 0, gw, NGW, scr, lane); cvt_run(a, CVT_S, 0, gw, NGW, scr, lane);
    const int gt = gw * 64 + lane, NGT = NGW * 64;
    for (int idx = gt; idx < DEPTH * 48 * D; idx += NGT) {
        const int l = idx / (48 * D), rem = idx - l * 48 * D, n = rem / D, k = rem - n * D;
        float w = 0.f; if (n < 4) w = a.in[9][((size_t)l * D + k) * 4 + n]; else if (n < 36) w = a.in[11][((size_t)l * D + k) * 32 + (n - 4)];
        const unsigned hi = f2bf(w); const float lo = w - __builtin_bit_cast(float, hi << 16);
        bf16* wr = (bf16*)(ws + WS_WL + (size_t)l * WL_STRIDE + WL_R);
        wr[n * D + k] = (bf16)hi; wr[48 * D + n * D + k] = (bf16)f2bf(lo);
    }
    for (int idx = gt; idx < SEQ * 8; idx += NGT) {
        const int pos = idx >> 3, i = idx & 7;
        const float inv = i == 0 ? 1.0f : i == 1 ? 0x1.8d275ep-3f : i == 2 ? 0x1.341190p-5f : i == 3 ? 0x1.ddee9cp-8f : i == 4 ? 0x1.72ba44p-10f : i == 5 ? 0x1.1f91f0p-12f : i == 6 ? 0x1.be2188p-15f : 0x1.5a0f4ep-17f;
        const float ang = (float)pos * inv;
        const double ad = (double)ang, kq = __builtin_rint(ad * 0.63661977236758134308);
        const double rr = __builtin_fma(-kq, 1.5707963267948966192, ad) - kq * 6.123233995736766e-17, r2 = rr * rr;
        const double sp = rr * (1.0 + r2 * (-1.0 / 6 + r2 * (1.0 / 120 + r2 * (-1.0 / 5040 + r2 * (1.0 / 362880 + r2 * (-1.0 / 39916800 + r2 * (1.0 / 6227020800.0)))))));
        const double cp = 1.0 + r2 * (-0.5 + r2 * (1.0 / 24 + r2 * (-1.0 / 720 + r2 * (1.0 / 40320 + r2 * (-1.0 / 3628800 + r2 * (1.0 / 479001600.0 + r2 * (-1.0 / 87178291200.0)))))));
        const int qd = (int)kq & 3;
        const double sn = qd == 0 ? sp : qd == 1 ? cp : qd == 2 ? -sp : -cp, cs = qd == 0 ? cp : qd == 1 ? -sp : qd == 2 ? -cp : sp;
        float* rp = (float*)(ws + WS_ROPE) + (size_t)pos * 16;
        rp[i] = (float)cs; rp[8 + i] = (float)sn;
    }
    for (int m = gw; m < M; m += NGW) norm_row(a.in[0] + (size_t)m * D, nullptr, nullptr, nullptr, a.in[1], (bf16*)(ws + WS_H) + (size_t)m * D, nullptr, lane);
}

constexpr int KS_STRIDE = 144, VT_OFF = 256 * KS_STRIDE, VT_STRIDE = 520;
__device__ __forceinline__ int crow(int r, int hi) { return (r & 3) + 8 * (r >> 2) + 4 * hi; }
__device__ __forceinline__ void attn_side_work(const Args& a, int l, LAS unsigned char* lds, int G, int vcu, int wave, int lane, int gu_lo);
__device__ __forceinline__ void phase_attn_conv(const Args& a, int l, LAS unsigned char* lds, int G, int vcu, int tid, int wave, int lane, int gu_lo) {
#define side_work() attn_side_work(a, l, lds, G, vcu, wave, lane, gu_lo)
    unsigned char* ws = a.ws;
    const bf16* P = (const bf16*)(ws + WS_P);
    bf16* AO = (bf16*)(ws + WS_AO);
    const float* sinks = a.in[3] + l * 16;
    const int j = lane & 31, h = lane >> 5;
    constexpr float LOG2E = 1.4426950408889634f;
    {   const int unit = blockIdx.x;
        const int qb = unit & 31, kvh = (unit >> 5) & 3, b = unit >> 7;
        const int q0 = qb * 128; const size_t rowbase = (size_t)b * SEQ;
#pragma unroll
        for (int it = 0; it < 4; ++it) {
            const int idx = it * 512 + tid, kl = idx >> 3, ch = idx & 7, pos = q0 - 128 + kl;
            v4u kv = {0u, 0u, 0u, 0u}, vv = kv;
            if (pos >= 0) { const bf16* src = P + (rowbase + pos) * INC + kvh * 64 + ch * 8; kv = *(const v4u*)(src + C_K); vv = *(const v4u*)(src + C_V); }
            *(LAS v4u*)(lds + kl * KS_STRIDE + ch * 16) = kv;
            LAS unsigned short* vt = (LAS unsigned short*)(lds + VT_OFF + (ch * 8) * VT_STRIDE + kl * 2);
            vt[0 * (VT_STRIDE / 2)] = (unsigned short)(vv.x & 0xffffu); vt[1 * (VT_STRIDE / 2)] = (unsigned short)(vv.x >> 16);
            vt[2 * (VT_STRIDE / 2)] = (unsigned short)(vv.y & 0xffffu); vt[3 * (VT_STRIDE / 2)] = (unsigned short)(vv.y >> 16);
            vt[4 * (VT_STRIDE / 2)] = (unsigned short)(vv.z & 0xffffu); vt[5 * (VT_STRIDE / 2)] = (unsigned short)(vv.z >> 16);
            vt[6 * (VT_STRIDE / 2)] = (unsigned short)(vv.w & 0xffffu); vt[7 * (VT_STRIDE / 2)] = (unsigned short)(vv.w >> 16);
        }
        __syncthreads();
        if (wave >= 4) side_work();
        else
#pragma unroll 1
        for (int tk = 0; tk < 4; ++tk) {
            const int task = wave + 4 * tk, hql = task >> 2, sub = task & 3, r0 = sub * 32, head = kvh * 4 + hql;
            const bf16* qrow = P + (rowbase + q0 + r0 + j) * INC + C_Q + head * 64 + h * 8;
            bf16x8 qf[4];
#pragma unroll
            for (int c = 0; c < 4; ++c) qf[c] = *(const bf16x8*)(qrow + 16 * c);
            f32x16 s[5];
#pragma unroll
            for (int kbi = 0; kbi < 5; ++kbi) {
                const int kl0 = 32 * (sub + kbi);
                f32x16 acc = {0.f, 0.f, 0.f, 0.f, 0.f, 0.f, 0.f, 0.f, 0.f, 0.f, 0.f, 0.f, 0.f, 0.f, 0.f, 0.f};
#pragma unroll
                for (int c = 0; c < 4; ++c) {
                    const bf16x8 kf = *(const LAS bf16x8*)(lds + (kl0 + j) * KS_STRIDE + (16 * c + 8 * h) * 2);
                    acc = __builtin_amdgcn_mfma_f32_32x32x16_bf16(kf, qf[c], acc, 0, 0, 0);
                }
                s[kbi] = acc;
                __builtin_amdgcn_sched_barrier(0);
            }
            const float sink = sinks[head] * LOG2E;
            float mx = sink;
#pragma unroll
            for (int kbi = 0; kbi < 5; ++kbi) {
                const int base = (qb == 0 && sub + kbi < 4) ? -4096 : (j + 128 - 32 * kbi - 4 * h);
#pragma unroll
                for (int i = 0; i < 16; ++i) {
                    const int dd = base - ((i & 3) + 8 * (i >> 2)), tt = min(dd, 127 - dd);
                    const float pen = __builtin_bit_cast(float, 0x7f800000u | ((unsigned)(tt >> 31) & 0x80000000u));
                    const float v = __builtin_fminf(s[kbi][i] * LOG2E, pen); s[kbi][i] = v; mx = __builtin_fmaxf(mx, v);
                }
            }
            mx = __builtin_fmaxf(mx, __shfl_xor(mx, 32));
            float lsum = 0.f;
#pragma unroll
            for (int kbi = 0; kbi < 5; ++kbi)
#pragma unroll
                for (int i = 0; i < 16; ++i) { const float p = __builtin_amdgcn_exp2f(s[kbi][i] - mx); s[kbi][i] = p; lsum += p; }
            lsum += __shfl_xor(lsum, 32);
            lsum += __builtin_amdgcn_exp2f(sink - mx);
            f32x16 o[2];
#pragma unroll
            for (int db = 0; db < 2; ++db) o[db] = (f32x16){0.f, 0.f, 0.f, 0.f, 0.f, 0.f, 0.f, 0.f, 0.f, 0.f, 0.f, 0.f, 0.f, 0.f, 0.f, 0.f};
#pragma unroll
            for (int kbi = 0; kbi < 5; ++kbi)
#pragma unroll
                for (int st = 0; st < 2; ++st) {
                    v4u pw; pw.x = pk2i(s[kbi][8 * st + 0], s[kbi][8 * st + 1]); pw.y = pk2i(s[kbi][8 * st + 2], s[kbi][8 * st + 3]);
                    pw.z = pk2i(s[kbi][8 * st + 4], s[kbi][8 * st + 5]); pw.w = pk2i(s[kbi][8 * st + 6], s[kbi][8 * st + 7]);
                    const bf16x8 pf = __builtin_bit_cast(bf16x8, pw);
#pragma unroll
                    for (int db = 0; db < 2; ++db) {
                        const int addr = VT_OFF + (32 * db + j) * VT_STRIDE + (32 * (sub + kbi) + 16 * st + 4 * h) * 2;
                        const s16x4 lo = *(const LAS s16x4*)(lds + addr), hi = *(const LAS s16x4*)(lds + addr + 16);
                        const bf16x8 vf = __builtin_shufflevector(lo, hi, 0, 1, 2, 3, 4, 5, 6, 7);
                        o[db] = __builtin_amdgcn_mfma_f32_32x32x16_bf16(vf, pf, o[db], 0, 0, 0);
                    }
                    __builtin_amdgcn_sched_barrier(0);
                }
            const float inv = 1.0f / lsum;
            bf16* orow = AO + (rowbase + q0 + r0 + j) * 1024 + head * 64 + 4 * h;
#pragma unroll
            for (int db = 0; db < 2; ++db)
#pragma unroll
                for (int g = 0; g < 4; ++g) {
                    v2u w; w.x = pk2i(o[db][4 * g + 0] * inv, o[db][4 * g + 1] * inv); w.y = pk2i(o[db][4 * g + 2] * inv, o[db][4 * g + 3] * inv);
                    *(v2u*)(orow + 32 * db + 8 * g) = w;
                }
        }
        __syncthreads();
    }
}
__device__ __forceinline__ void attn_side_work(const Args& a, int l, LAS unsigned char* lds, int G, int vcu, int wave, int lane_in, int gu_lo) {
    int lane = lane_in; asm volatile("" : "+v"(lane));
    unsigned char* ws = a.ws;
    const bf16* P = (const bf16*)(ws + WS_P);
    bf16* CV = (bf16*)(ws + WS_CV);
    const float* cw = a.in[5] + (size_t)l * 3 * 1024;
    for (int it = blockIdx.x * 256 + (wave - 4) * 64 + lane; it < 1024 * 128; it += G * 256) {
        const int ch = it & 127, t0 = (it >> 7) * 8, c0 = ch * 8;
        float w0[8], w1[8], w2[8], u1[8], u2[8];
#pragma unroll
        for (int e = 0; e < 8; ++e) { w0[e] = cw[c0 + e]; w1[e] = cw[1024 + c0 + e]; w2[e] = cw[2048 + c0 + e]; u1[e] = 0.f; u2[e] = 0.f; }
        if ((t0 & (SEQ - 1)) != 0) {
            const bf16* p2 = P + (size_t)(t0 - 2) * INC + c0; const bf16* p1 = p2 + INC;
            const v4u c2 = *(const v4u*)(p2 + C_CC), x2 = *(const v4u*)(p2 + C_CX), c1 = *(const v4u*)(p1 + C_CC), x1 = *(const v4u*)(p1 + C_CX);
            u2[0] = bflo(c2.x) * bflo(x2.x); u2[1] = bfhi(c2.x) * bfhi(x2.x); u2[2] = bflo(c2.y) * bflo(x2.y); u2[3] = bfhi(c2.y) * bfhi(x2.y);
            u2[4] = bflo(c2.z) * bflo(x2.z); u2[5] = bfhi(c2.z) * bfhi(x2.z); u2[6] = bflo(c2.w) * bflo(x2.w); u2[7] = bfhi(c2.w) * bfhi(x2.w);
            u1[0] = bflo(c1.x) * bflo(x1.x); u1[1] = bfhi(c1.x) * bfhi(x1.x); u1[2] = bflo(c1.y) * bflo(x1.y); u1[3] = bfhi(c1.y) * bfhi(x1.y);
            u1[4] = bflo(c1.z) * bflo(x1.z); u1[5] = bfhi(c1.z) * bfhi(x1.z); u1[6] = bflo(c1.w) * bflo(x1.w); u1[7] = bfhi(c1.w) * bfhi(x1.w);
        }
#pragma unroll
        for (int t = 0; t < 8; ++t) {
            const bf16* pp = P + (size_t)(t0 + t) * INC + c0;
            const v4u cc = *(const v4u*)(pp + C_CC), cx = *(const v4u*)(pp + C_CX), cb = *(const v4u*)(pp + C_CB);
            float u0[8], bb[8], y[8];
            u0[0] = bflo(cc.x) * bflo(cx.x); u0[1] = bfhi(cc.x) * bfhi(cx.x); u0[2] = bflo(cc.y) * bflo(cx.y); u0[3] = bfhi(cc.y) * bfhi(cx.y);
            u0[4] = bflo(cc.z) * bflo(cx.z); u0[5] = bfhi(cc.z) * bfhi(cx.z); u0[6] = bflo(cc.w) * bflo(cx.w); u0[7] = bfhi(cc.w) * bfhi(cx.w);
            bb[0] = bflo(cb.x); bb[1] = bfhi(cb.x); bb[2] = bflo(cb.y); bb[3] = bfhi(cb.y); bb[4] = bflo(cb.z); bb[5] = bfhi(cb.z); bb[6] = bflo(cb.w); bb[7] = bfhi(cb.w);
#pragma unroll
            for (int e = 0; e < 8; ++e) { y[e] = bb[e] * (w0[e] * u2[e] + w1[e] * u1[e] + w2[e] * u0[e]); u2[e] = u1[e]; u1[e] = u0[e]; }
            v4u o; o.x = pk2(y[0], y[1]); o.y = pk2(y[2], y[3]); o.z = pk2(y[4], y[5]); o.w = pk2(y[6], y[7]);
            *(v4u*)(CV + (size_t)(t0 + t) * 1024 + c0) = o;
        }
    }
    cvt_run(a, CVT_GU, l, vcu * 4 + (wave - 4), G * 4, (LAS float*)(lds + 81920 + (wave - 4) * 8704), lane, gu_lo, 1 << 30);
}

__device__ __forceinline__ void phase_norm_router(const Args& a, int l, LAS unsigned char* lds, int G, int tid, int wave, int lane, int bank) {
    unsigned char* ws = a.ws;
    const bf16* HX = (const bf16*)(ws + WS_H);
    const float* part = (const float*)(ws + WS_PART);
    const bf16* Wh = (const bf16*)(ws + WS_WL + (size_t)l * WL_STRIDE + WL_R); const bf16* Wl = Wh + 48 * D;
    const float* bg = a.in[10] + l * 4; const float* br = a.in[12] + l * 32;
    unsigned* cnt = (unsigned*)(ws + WS_CTL) + CW_CNT + l * 64 + bank * 128;
    int* tok = (int*)(ws + WS_TOK); float* wgt = (float*)(ws + WS_WGT); float* rsl = (float*)(ws + WS_RSL);
    LAS float* red = (LAS float*)lds;
    LAS float* lg = (LAS float*)(lds + 49152);
    LAS float* rs = (LAS float*)(lds + 49152 + 6144);
    const int r = lane & 15, q = lane >> 4;
    for (int blk = blockIdx.x; blk < M / 32; blk += G) {
        const int row0 = blk * 32;
        if (tid < 32) { const f32x4* pp = (const f32x4*)(part + (size_t)(row0 + tid) * 32); float t = 0.f;
#pragma unroll
            for (int i = 0; i < 8; ++i) { const f32x4 v = pp[i]; t += (v.x + v.y) + (v.z + v.w); }
            rs[tid] = 1.0f / sqrtf(t * (1.f / D) + NORM_EPS); }
        bf16x8 xa[2][8];
#pragma unroll
        for (int rg = 0; rg < 2; ++rg)
#pragma unroll
            for (int jj = 0; jj < 8; ++jj) xa[rg][jj] = *(const bf16x8*)(HX + (size_t)(row0 + 16 * rg + r) * D + 256 * wave + 32 * jj + 8 * q);
        f32x4 acc[2][3];
#pragma unroll
        for (int rg = 0; rg < 2; ++rg)
#pragma unroll
            for (int cb = 0; cb < 3; ++cb) acc[rg][cb] = (f32x4){0.f, 0.f, 0.f, 0.f};
#pragma unroll
        for (int jj = 0; jj < 8; ++jj) {
#pragma unroll
            for (int cb = 0; cb < 3; ++cb) {
                const size_t o = (size_t)(16 * cb + r) * D + 256 * wave + 32 * jj + 8 * q;
                const bf16x8 wh = *(const bf16x8*)(Wh + o), wl = *(const bf16x8*)(Wl + o);
#pragma unroll
                for (int rg = 0; rg < 2; ++rg) {
                    acc[rg][cb] = __builtin_amdgcn_mfma_f32_16x16x32_bf16(wh, xa[rg][jj], acc[rg][cb], 0, 0, 0);
                    acc[rg][cb] = __builtin_amdgcn_mfma_f32_16x16x32_bf16(wl, xa[rg][jj], acc[rg][cb], 0, 0, 0);
                }
            }
        }
#pragma unroll
        for (int rg = 0; rg < 2; ++rg)
#pragma unroll
            for (int cb = 0; cb < 3; ++cb) *(LAS f32x4*)(red + (wave * 32 + 16 * rg + r) * 48 + 16 * cb + 4 * q) = acc[rg][cb];
        __syncthreads();
        for (int idx = tid; idx < 32 * 48; idx += 512) { float t = 0.f;
#pragma unroll
            for (int w = 0; w < 8; ++w) t += red[w * 1536 + idx];
            lg[idx] = t; }
        __syncthreads();
        if (tid < 32) {
            const float rsd = rs[tid]; const LAS float* lr = lg + tid * 48;
            float gl0 = lr[0] * rsd + bg[0], gl1 = lr[1] * rsd + bg[1], gl2 = lr[2] * rsd + bg[2], gl3 = lr[3] * rsd + bg[3];
            int gi = 0; float gm = gl0;
            if (gl1 > gm) { gm = gl1; gi = 1; } if (gl2 > gm) { gm = gl2; gi = 2; } if (gl3 > gm) { gm = gl3; gi = 3; }
            const float gw = 1.0f / (__expf(gl0 - gm) + __expf(gl1 - gm) + __expf(gl2 - gm) + __expf(gl3 - gm));
            float sv[8];
#pragma unroll
            for (int e = 0; e < 8; ++e) sv[e] = lr[4 + gi * 8 + e] * rsd + br[gi * 8 + e];
            int i1 = 0; float m1 = sv[0];
#pragma unroll
            for (int e = 1; e < 8; ++e) if (sv[e] > m1) { m1 = sv[e]; i1 = e; }
            int i2 = (i1 + 1) & 7; float m2 = -INFINITY;
#pragma unroll
            for (int e = 0; e < 8; ++e) if (e != i1 && sv[e] > m2) { m2 = sv[e]; i2 = e; }
            const float p2 = __expf(m2 - m1), w1 = gw / (1.0f + p2), w2 = gw * p2 / (1.0f + p2);
            const int e1 = gi * 8 + i1, e2 = gi * 8 + i2, token = row0 + tid;
            const unsigned pos1 = __hip_atomic_fetch_add(cnt + e1, 1u, RLX_AGENT), pos2 = __hip_atomic_fetch_add(cnt + e2, 1u, RLX_AGENT);
            tok[(size_t)e1 * M + pos1] = token * 2; wgt[(size_t)e1 * M + pos1] = w1; rsl[(size_t)e1 * M + pos1] = rsd;
            tok[(size_t)e2 * M + pos2] = token * 2 + 1; wgt[(size_t)e2 * M + pos2] = w2; rsl[(size_t)e2 * M + pos2] = rsd;
        }
        __syncthreads();
    }
}

__device__ __forceinline__ int moe_tables(const Args& a, int l, LAS unsigned char* lds, int tid) {
    LAS int* tile_e = (LAS int*)(lds + TILE_OFF); LAS int* tile_mt = tile_e + 128; LAS int* lcnt = tile_e + 256; LAS int* lnt = tile_e + 288;
    const unsigned* cnt = (const unsigned*)(a.ws + WS_CTL) + CW_CNT + l * 64;
    if (tid < 64) {
        const int c = tid < 32 ? (int)__hip_atomic_load(cnt + tid, RLX_AGENT) : 0, n = (c + 255) >> 8;
        int inc = n;
#pragma unroll
        for (int o = 1; o < 32; o <<= 1) { const int t = __shfl_up(inc, o); if (tid >= o) inc += t; }
        const int start = inc - n;
        if (tid < 32) { lcnt[tid] = c;
#pragma unroll 1
            for (int mt = 0; mt < n; ++mt) { if (start + mt < 128) { tile_e[start + mt] = tid; tile_mt[start + mt] = mt; } } }
        if (tid == 31) lnt[0] = inc < 128 ? inc : 128;
    }
    __syncthreads();
    return lnt[0];
}

__global__ void __launch_bounds__(NWAVES * 64, 2) mk_fwd(Args args) {
    extern __shared__ __attribute__((aligned(16))) unsigned char lds_raw[];
    LAS unsigned char* lds = (LAS unsigned char*)lds_raw;
    volatile LAS unsigned* MISC = (volatile LAS unsigned*)(lds + MISC_OFF);
    const int G = gridDim.x; const int bx = blockIdx.x; const int vcu = (G % 8 == 0) ? (bx % 8) * (G / 8) + bx / 8 : bx;
    unsigned char* ws = args.ws;
    gu32* ctl = (gu32*)(ws + WS_CTL);
    for (int u = threadIdx.x; u < (LDS_BYTES - LDSCTL_OFF) / 4; u += NWAVES * 64) ((LAS unsigned*)(lds + LDSCTL_OFF))[u] = 0u;
    __syncthreads();
    XcdBarrier bar; bar.bar = (unsigned*)ctl + CW_BAR; bar.x = 0; bar.st = nullptr;
    if (MK_N_LAUNCHES == 1) bar = xcd_barrier_post((unsigned*)ctl + CW_BAR, MISC + 8);
#ifndef MK_BAR_REP
#define MK_BAR_REP 1
#endif
#define GRID_BAR() do { if (MK_N_LAUNCHES == 1) { _Pragma("unroll 1") for (int br_ = 0; br_ < MK_BAR_REP; ++br_) xcd_barrier(bar); } } while (0)
    const int lo = args.ph_lo, hi = args.ph_hi;
#ifndef PH_MASK
#define PH_MASK 0x1ff
#endif
#define PHON(j) (((PH_MASK) >> (j)) & 1)
#define IN(k) (lo <= (k) && (k) < hi)
#define BOTH(k) (IN(k) && IN((k) + 1))

#define PHASE_IDS() int tid_ = threadIdx.x; asm volatile("" : "+v"(tid_)); const int tid = tid_, lane = tid & 63, wave = __builtin_amdgcn_readfirstlane(tid >> 6); (void)tid; (void)lane; (void)wave
    if (PHON(0) && IN(0)) { PHASE_IDS(); REP(0, true) phase_prologue(args, lds, vcu, G, wave, lane); if (BOTH(0)) GRID_BAR(); }

    constexpr int GU_SPLIT = 22528;
    constexpr int WIN_EARLY = 4096;
    constexpr int NG2 = 218;
    for (int l = 0; l < DEPTH; ++l) {
        const int pb = 1 + 8 * l;
        unsigned char* wl = ws + WS_WL + (size_t)l * WL_STRIDE;
        if (PHON(1) && IN(pb + 0)) {
            PHASE_IDS();
            if (bx >= NG2) { cvt_run(args, CVT_GU, l, (bx - NG2) * NWAVES + wave, (256 - NG2) * NWAVES, (LAS float*)(lds + wave * 16384), lane, 0, GU_SPLIT);
                if (l + 1 < DEPTH) cvt_run(args, CVT_WIN, l + 1, (bx - NG2) * NWAVES + wave, (256 - NG2) * NWAVES, (LAS float*)(lds + wave * 16384), lane, 0, WIN_EARLY); }
            if (bx < NG2) {
            SchedPlain S; S.T.init(M, INC, NG2, bx); S.A = (const char*)(ws + WS_H); S.Bt = (const char*)(wl + WL_IN); S.tstep = (size_t)256 * D * 2;
            EpiInProj E{(bf16*)(ws + WS_P), (const float*)(ws + WS_ROPE)};
            REP(1, true) pg8::gemm_phase<EpiInProj, SchedPlain, true, false>(lds, D, S, E);
            }
            if (BOTH(pb + 0)) GRID_BAR();
        }
        if (PHON(2) && IN(pb + 1)) { PHASE_IDS(); REP(2, true) phase_attn_conv(args, l, lds, G, vcu, tid, wave, lane, GU_SPLIT); if (BOTH(pb + 1)) GRID_BAR(); }
        if (PHON(3) && IN(pb + 2)) {
            SchedPair S; S.T.init(M, D, G, bx); S.A0 = (const char*)(ws + WS_AO); S.A1 = (const char*)(ws + WS_CV); S.B0 = (const char*)(wl + WL_A); S.B1 = (const char*)(wl + WL_C); S.tstep = (size_t)256 * 1024 * 2;
            EpiMerge E{(const bf16*)(ws + WS_P), (bf16*)(ws + WS_MG)};
            REP(3, true) pg8::gemm_phase<EpiMerge, SchedPair, true, false>(lds, 1024, S, E);
            if (BOTH(pb + 2)) GRID_BAR();
        }
        if (PHON(4) && IN(pb + 3)) {
            SchedPlain S; S.T.init(M, D, G, bx); S.A = (const char*)(ws + WS_MG); S.Bt = (const char*)(wl + WL_O); S.tstep = (size_t)256 * D * 2;
            EpiResHx E{l == 0 ? args.in[0] : (const float*)(ws + WS_XRES), (float*)(ws + WS_XRES), (bf16*)(ws + WS_H), args.in[8] + (size_t)l * D, (float*)(ws + WS_PART)};
            REP(4, l == 0) pg8::gemm_phase<EpiResHx, SchedPlain, true, false>(lds, D, S, E);
            if (BOTH(pb + 3)) GRID_BAR();
        }
        if (PHON(5) && IN(pb + 4)) { PHASE_IDS(); REP(5, true) phase_norm_router(args, l, lds, G, tid, wave, lane, rep_); if (BOTH(pb + 4)) GRID_BAR(); }
        if (PHON(6) && IN(pb + 5)) {
            PHASE_IDS();
            const int ntiles = moe_tables(args, l, lds, tid);
            int NG7; { const int th = (ntiles + 1) >> 1, rounds = (th + 27) / 28, per = (th + rounds - 1) / rounds; NG7 = 8 * per; }
            if (bx >= NG7) { const int cw = (bx - NG7) * NWAVES + wave, cn = (256 - NG7) * NWAVES; LAS float* scr = (LAS float*)(lds + wave * 16384);
                cvt_run(args, CVT_B, l, cw, cn, scr, lane);
                if (l + 1 < DEPTH) { cvt_run(args, CVT_WIN, l + 1, cw, cn, scr, lane, WIN_EARLY, 1 << 30); if ((ntiles * 8 + 223) / 224 != (ntiles * 8 + 255) / 256) cvt_run(args, CVT_S, l + 1, cw, cn, scr, lane); } }
            if (bx < NG7) {
            LAS int* tile_e = (LAS int*)(lds + TILE_OFF); LAS int* tile_mt = tile_e + 128; LAS int* lcnt = tile_e + 256;
            LAS unsigned* gtab = (LAS unsigned*)(lds + GTAB_OFF);
            const int* tok = (const int*)(ws + WS_TOK);
            for (int idx = tid; idx < 4 * 256; idx += 512) {
                const int ui = idx >> 8, rr = idx & 255; unsigned off = 0u;
                const int th = (ntiles + 1) >> 1, t = ui * (NG7 >> 3) + (bx >> 3), tile = ((bx & 7) >> 2) * th + t;
                if (t < th && tile < ntiles) { const int e = tile_e[tile], pos = tile_mt[tile] * 256 + rr; if (pos < lcnt[e]) off = (unsigned)(tok[(size_t)e * M + pos] >> 1) * (unsigned)(D * 2); }
                gtab[idx] = off;
            }
            __syncthreads();
            SchedMoe S; S.tile_e = tile_e; S.tile_mt = tile_mt; S.gtab = gtab; S.ntiles = ntiles; S.nN = 4; S.G = NG7; S.c = bx;
            S.A = (const char*)(ws + WS_H); S.Bt = (const char*)(wl + WL_GU); S.a_tstep = 0; S.b_estep = (size_t)1024 * D * 2; S.b_tstep = (size_t)256 * D * 2; S.gather = true;
            EpiMoeGU E{(bf16*)(ws + WS_ACT), (const float*)(ws + WS_WGT), (const float*)(ws + WS_RSL), lcnt};
            REP(6, true) pg8::gemm_phase<EpiMoeGU, SchedMoe, true, true>(lds, D, S, E);
            }
            if (BOTH(pb + 5)) GRID_BAR();
        }
        if (PHON(7) && IN(pb + 6)) {
            PHASE_IDS();
            const int ntiles = (MK_N_LAUNCHES == 1) ? ((LAS int*)(lds + TILE_OFF))[288] : moe_tables(args, l, lds, tid);
            const int NG8 = (l + 1 < DEPTH && (ntiles * 8 + 223) / 224 == (ntiles * 8 + 255) / 256) ? 224 : 256;
            if (bx >= NG8 && l + 1 < DEPTH) cvt_run(args, CVT_S, l + 1, (bx - NG8) * NWAVES + wave, (256 - NG8) * NWAVES, (LAS float*)(lds + wave * 16384), lane);
            if (bx < NG8) {
            LAS int* tile_e = (LAS int*)(lds + TILE_OFF); LAS int* tile_mt = tile_e + 128; LAS int* lcnt = tile_e + 256;
            SchedMoe S; S.tile_e = tile_e; S.tile_mt = tile_mt; S.gtab = (LAS unsigned*)(lds + GTAB_OFF); S.ntiles = ntiles; S.nN = 8; S.G = NG8; S.c = bx;
            S.A = (const char*)(ws + WS_ACT); S.Bt = (const char*)(wl + WL_D); S.a_tstep = (size_t)256 * FF * 2; S.b_estep = (size_t)D * FF * 2; S.b_tstep = (size_t)256 * FF * 2; S.gather = false;
            EpiMoeDown E{(bf16*)(ws + WS_Y2), (const int*)(ws + WS_TOK), lcnt};
            REP(7, true) pg8::gemm_phase<EpiMoeDown, SchedMoe, true, false>(lds, FF, S, E);
            }
            if (BOTH(pb + 6)) GRID_BAR();
        }
        if (PHON(8) && IN(pb + 7)) {
            PHASE_IDS();
            const int gw = vcu * NWAVES + wave, NGW = G * NWAVES;
            float* X = (float*)(ws + WS_XRES); const bf16* Y2 = (const bf16*)(ws + WS_Y2);
            REP(8, l + 1 == DEPTH) for (int m = gw; m < M; m += NGW) {
                if (l + 1 < DEPTH) norm_row(X + (size_t)m * D, Y2 + (size_t)(2 * m) * D, Y2 + (size_t)(2 * m + 1) * D, X + (size_t)m * D, args.in[1] + (size_t)(l + 1) * D, (bf16*)(ws + WS_H) + (size_t)m * D, nullptr, lane);
                else norm_row(X + (size_t)m * D, Y2 + (size_t)(2 * m) * D, Y2 + (size_t)(2 * m + 1) * D, nullptr, args.in[16], nullptr, args.out + (size_t)m * D, lane);
            }
            if (BOTH(pb + 7)) GRID_BAR();
        }
    }
#undef IN
#undef BOTH
}

extern "C" void kernel_launch(void* const* d_in, const int* in_sizes, int n_in, void* d_out, int out_size, void* d_ws, size_t ws_size, hipStream_t stream) {
    static int grid = 0;
    if (grid == 0) {
        if (n_in != 17 || in_sizes[0] != M * D || out_size != M * D || ws_size < WS_END) { fprintf(stderr, "kernel_launch: unexpected shapes (n_in %d, in0 %d, out %d, ws %zu)\n", n_in, n_in > 0 ? in_sizes[0] : -1, out_size, ws_size); grid = -1; return; }
        int dev = 0, cus = 0, per_cu = 0;
        if (hipGetDevice(&dev) != hipSuccess || hipDeviceGetAttribute(&cus, hipDeviceAttributeMultiprocessorCount, dev) != hipSuccess) { grid = -1; return; }
        if (hipFuncSetAttribute((const void*)mk_fwd, hipFuncAttributeMaxDynamicSharedMemorySize, LDS_BYTES) != hipSuccess) { fprintf(stderr, "kernel_launch: hipFuncSetAttribute failed\n"); grid = -1; return; }
        if (hipOccupancyMaxActiveBlocksPerMultiprocessor(&per_cu, (const void*)mk_fwd, NWAVES * 64, LDS_BYTES) != hipSuccess || per_cu < 1)
            fprintf(stderr, "kernel_launch: occupancy query reports %d workgroups per CU\n", per_cu);
        (void)hipGetLastError();
        if (cus != 256) { fprintf(stderr, "kernel_launch: built for a 256-CU device (got %d CUs); nothing launched\n", cus); grid = -1; return; }
        grid = cus;
    }
    if (grid < 0) return;
    if (hipMemsetAsync((char*)d_ws + WS_CTL, 0, CTL_ZERO_BYTES, stream) != hipSuccess) return;
    Args a{};
    for (int i = 0; i < 17; ++i) a.in[i] = (const float*)d_in[i];
    a.out = (float*)d_out; a.ws = (unsigned char*)d_ws;
    if (MK_N_LAUNCHES == 1) {
        a.ph_lo = 0; a.ph_hi = NPHASE; a.li = 0;
        hipLaunchKernelGGL(mk_fwd, dim3(grid), dim3(NWAVES * 64), LDS_BYTES, stream, a);
    } else {
        for (int p = 0; p < MK_PH_END; ++p) { a.ph_lo = p; a.ph_hi = p + 1; a.li = p; hipLaunchKernelGGL(mk_fwd, dim3(grid), dim3(NWAVES * 64), LDS_BYTES, stream, a); }
    }
    const hipError_t le = hipPeekAtLastError();
    if (le != hipSuccess) fprintf(stderr, "kernel_launch: launch failed: %s\n", hipGetErrorName(le));
}
```

```cpp
#include <hip/hip_runtime.h>
#include <cstdio>
#include <cstdint>

#ifndef MK_REPEAT
#define MK_REPEAT 0
#endif
#define REP(k, cond) _Pragma("unroll 1") for (int rep_ = 0; rep_ < 1 + ((((MK_REPEAT) >> (k)) & 1) && (cond) ? 1 : 0); ++rep_)
#ifndef MK_PH_END
#define MK_PH_END 17
#endif
#ifndef MK_PACE7
#define MK_PACE7 2
#endif
#ifndef MK_PACE2
#define MK_PACE2 0
#endif
#ifndef MK_N_LAUNCHES
#define MK_N_LAUNCHES 1
#endif

constexpr int D = 2048, SEQ = 4096, M = 8192, DEPTH = 2;
constexpr int INC = 8704;
constexpr int C_Q = 0, C_K = 1024, C_V = 1280, C_CB = 1536, C_CC = 2560, C_CX = 3584, C_GA = 4608, C_GC = 6656;
constexpr int NE = 32, FF = 512;
constexpr float NORM_EPS = 1e-5f;
constexpr int NPHASE = 1 + 8 * DEPTH;

constexpr size_t MiB = 1u << 20;
constexpr size_t WS_CTL = 0, CTL_ZERO_BYTES = 128 * 1024;
constexpr size_t WS_ROPE = 1 * MiB;
constexpr size_t WS_TOK = 2 * MiB;
constexpr size_t WS_WGT = 3 * MiB;
constexpr size_t WS_WL = 4 * MiB, WL_STRIDE = 243 * MiB;
constexpr size_t WL_IN = 0, WL_A = 34 * MiB, WL_C = 38 * MiB, WL_O = 42 * MiB, WL_GU = 50 * MiB, WL_D = 178 * MiB, WL_R = 242 * MiB;
constexpr size_t WR_LO_OFF = 48 * 2048 * 2;
constexpr size_t WS_XRES = 490 * MiB;
constexpr size_t WS_H = 554 * MiB;
constexpr size_t WS_P = 586 * MiB;
constexpr size_t WS_Y2 = WS_P;
constexpr size_t WS_AO = 722 * MiB, WS_CV = 738 * MiB;
constexpr size_t WS_PART = 754 * MiB;
constexpr size_t WS_RSL = 756 * MiB;
constexpr size_t WS_MG = 818 * MiB;
constexpr size_t WS_ACT = 850 * MiB;
constexpr size_t WS_END = 874 * MiB;
constexpr int CW_TMO = 0, CW_CODE = 1, CW_BAR = 4096, CW_CNT = 16384;

constexpr int RING_BYTES = 131072;
constexpr int LDSCTL_OFF = RING_BYTES;
constexpr int MISC_OFF = LDSCTL_OFF + 320;
constexpr int TILE_OFF = LDSCTL_OFF + 1024;
constexpr int GTAB_OFF = LDSCTL_OFF + 4096;
constexpr int LTAB_OFF = LDSCTL_OFF + 8192;
constexpr int RB = 4;
constexpr int GU_SPLIT2 = 32768 - 3584;
constexpr int NSHARD = 8, SHARD_CAP = 1024;
constexpr int LDS_BYTES = 147456;
constexpr int NWAVES = 8;

#define GAS __attribute__((address_space(1)))
#define LAS __attribute__((address_space(3)))
typedef unsigned short bf16;
typedef unsigned v4u __attribute__((ext_vector_type(4)));
typedef unsigned v2u __attribute__((ext_vector_type(2)));
typedef float f32x4 __attribute__((ext_vector_type(4)));
typedef float f32x16 __attribute__((ext_vector_type(16)));
typedef short bf16x8 __attribute__((ext_vector_type(8)));
typedef short s16x4 __attribute__((ext_vector_type(4)));
typedef GAS unsigned gu32;
#define RLX_AGENT __ATOMIC_RELAXED, __HIP_MEMORY_SCOPE_AGENT
#define LDS_WAIT() asm volatile("s_waitcnt lgkmcnt(0)" ::: "memory")
#define VM_WAIT() asm volatile("s_waitcnt vmcnt(0)" ::: "memory")

__device__ __forceinline__ unsigned f2bf(float f) { unsigned u = __builtin_bit_cast(unsigned, f); return (u + 0x7fffu + ((u >> 16) & 1u)) >> 16; }
__device__ __forceinline__ unsigned pk2i(float lo, float hi) { return f2bf(lo) | (f2bf(hi) << 16); }
typedef float f32x2_t __attribute__((ext_vector_type(2))); typedef __bf16 bf16x2_t __attribute__((ext_vector_type(2)));
__device__ __forceinline__ unsigned pk2(float lo, float hi) { const f32x2_t v = {lo, hi}; const bf16x2_t b = __builtin_convertvector(v, bf16x2_t); return __builtin_bit_cast(unsigned, b); }
__device__ __forceinline__ float bflo(unsigned w) { return __builtin_bit_cast(float, w << 16); }
__device__ __forceinline__ float bfhi(unsigned w) { return __builtin_bit_cast(float, w & 0xffff0000u); }
__device__ __forceinline__ float sigmoidf_(float v) { return __builtin_amdgcn_rcpf(1.0f + __expf(-v)); }

namespace pg8 {
#define PG8_LAS __attribute__((address_space(3)))
typedef unsigned short bf16_t;
constexpr int BM = 256, BK = 64, HALF = 128, HTB = HALF * BK * 2, STAGE_BYTES = 8 * HTB, NXCD = 8, WGM = 8;

__host__ __device__ __forceinline__ int lds_byte(int r, int c) { const int st = (r >> 4) * 2 + (c >> 5), rr = r & 15, cc = c & 31, ob = rr * 64 + cc * 2; return st * 1024 + (ob ^ (((ob >> 9) & 1) << 5)); }
__host__ __device__ __forceinline__ void stage_rc(int b, int& R, int& C) { const int st = b / 1024, sb = b % 1024, swz = sb ^ (((sb >> 9) & 1) << 5); R = (st >> 1) * 16 + swz / 64; C = (st & 1) * 32 + (swz % 64) / 2; }
__host__ __device__ __forceinline__ int perm32(int rho) { const int n = rho >> 4, i = rho & 15; return 8 * (i >> 2) + 4 * n + (i & 3); }

struct Unit { int pm, pn, aux; };

struct TileOrder {
    int nM, nN, nwg, G, c;
    __device__ void init(int Mr, int Nc, int G_, int c_) { nM = Mr / BM; nN = Nc / BM; nwg = nM * nN; G = G_; c = c_; }
    __device__ bool tile(int i, int& pm, int& pn) const {
        const long L = (long)i * G + c; if (L >= nwg) return false;
        int wgid = (int)L; { const int q = nwg / NXCD, r = nwg % NXCD, xcd = wgid % NXCD, off = wgid / NXCD; wgid = (xcd < r ? xcd * (q + 1) : r * (q + 1) + (xcd - r) * q) + off; }
        const int nig = WGM * nN, gid = wgid / nig, fm = gid * WGM, gsz = (nM - fm) < WGM ? (nM - fm) : WGM;
        pm = fm + ((wgid % nig) % gsz); pn = (wgid % nig) / gsz; return true;
    }
};

template <class Epi, class Sched, bool ALIGN_EPI, bool GATHER>
__device__ __forceinline__ void gemm_phase(PG8_LAS unsigned char* lds, const int K, const Sched& S, const Epi& E) {
    int tid_ = threadIdx.x; asm volatile("" : "+v"(tid_));
    const int tid = tid_, wid = __builtin_amdgcn_readfirstlane(tid >> 6), lane = tid & 63, wr = wid >> 2, wc = wid & 3, fr = lane & 15, fq = lane >> 4;
    const int nt = K / BK;
    unsigned voffA[2], voffB[2]; int RA[2]; unsigned CA[2];
#pragma unroll
    for (int i = 0; i < 2; ++i) { int R, C; stage_rc(tid * 16 + i * 8192, R, C); const int Rb = Epi::PERM ? ((R & ~31) + perm32(R & 31)) : R;
        voffA[i] = (unsigned)(R * K + C) * 2u; voffB[i] = (unsigned)(Rb * K + C) * 2u; RA[i] = R; CA[i] = (unsigned)C * 2u; }
    const size_t kstep = (size_t)(BK * 2);
    const size_t hstep = (size_t)HALF * K * 2;
    const unsigned ldsw = (unsigned)wid * 1024u;
    const int aoff = lds_byte(wr * 64 + fr, fq * 8), boff = lds_byte(wc * 32 + fr, fq * 8);
    unsigned gvo[2][2], ngvo[2][2];
#define PG8_SA(b, h) (((b) * 2 + (h)) * HTB)
#define PG8_SB(b, h) ((4 + (b) * 2 + (h)) * HTB)
#define PG8_STAGE2(bufoff, gbase, v0, v1) do { \
        __builtin_amdgcn_global_load_lds((const unsigned*)((const char*)(gbase) + (v0)), (PG8_LAS unsigned*)(lds + (bufoff) + ldsw), 16, 0, 0); \
        __builtin_amdgcn_global_load_lds((const unsigned*)((const char*)(gbase) + (v1)), (PG8_LAS unsigned*)(lds + (bufoff) + ldsw + 8192), 16, 0, 0); } while (0)
#define PG8_STAGE_B(bufoff, gbase) PG8_STAGE2(bufoff, gbase, voffB[0], voffB[1])
#define PG8_STAGE_A(bufoff, kbase, h, nx) do { if constexpr (GATHER) { const unsigned _v0 = (nx) ? ngvo[h][0] : gvo[h][0], _v1 = (nx) ? ngvo[h][1] : gvo[h][1]; PG8_STAGE2(bufoff, kbase, _v0, _v1); } \
        else { PG8_STAGE2(bufoff, (kbase) + (h) * hstep, voffA[0], voffA[1]); } } while (0)
#define PG8_LDA(dst, b, h) do { _Pragma("unroll") for (int m = 0; m < 4; ++m) _Pragma("unroll") for (int k = 0; k < 2; ++k) dst[m][k] = *(const PG8_LAS bf16x8*)(lds + PG8_SA(b, h) + aoff + m * 2048 + k * 1024); } while (0)
#define PG8_LDB(dst, b, h) do { _Pragma("unroll") for (int n = 0; n < 2; ++n) _Pragma("unroll") for (int k = 0; k < 2; ++k) dst[n][k] = *(const PG8_LAS bf16x8*)(lds + PG8_SB(b, h) + boff + n * 2048 + k * 1024); } while (0)
#define PG8_MMA(ai, bj, At, Bt) do { __builtin_amdgcn_s_setprio(1); _Pragma("unroll") for (int m = 0; m < 4; ++m) _Pragma("unroll") for (int n = 0; n < 2; ++n) _Pragma("unroll") for (int k = 0; k < 2; ++k) \
        acc[ai][bj][m][n] = __builtin_amdgcn_mfma_f32_16x16x32_bf16(Bt[n][k], At[m][k], acc[ai][bj][m][n], 0, 0, 0); __builtin_amdgcn_s_setprio(0); } while (0)
#define PG8_WAIT_V(n) asm volatile("s_waitcnt vmcnt(" #n ")" ::: "memory")
#define PG8_WAIT_L(n) asm volatile("s_waitcnt lgkmcnt(" #n ")" ::: "memory")
#define PG8_BAR __builtin_amdgcn_s_barrier()
#define PG8_SCHED __builtin_amdgcn_sched_barrier(0)
    Unit cur, nxt; int ui = 0;
    if (!S.next(0, cur)) return;
    f32x4 acc[2][2][4][2];
    E.init(acc, cur, wr, wc, fr, fq);
    bf16x8 At[4][2], B0[2][2], B1[2][2];
    const char* cA = S.abase(cur); const char* cB = S.bbase(cur);
    if constexpr (GATHER) {
#pragma unroll
        for (int h = 0; h < 2; ++h)
#pragma unroll
            for (int i = 0; i < 2; ++i) { gvo[h][i] = S.goff(0, h * HALF + RA[i]) + CA[i]; ngvo[h][i] = gvo[h][i]; }
    }
    PG8_STAGE_B(PG8_SB(0, 0), cB); PG8_STAGE_B(PG8_SB(0, 1), cB + hstep); PG8_STAGE_A(PG8_SA(0, 0), cA, 0, false); PG8_STAGE_A(PG8_SA(0, 1), cA, 1, false);
    if (wr == 1) PG8_BAR;
    PG8_WAIT_V(2); PG8_BAR;
    PG8_STAGE_B(PG8_SB(1, 0), cB + kstep); PG8_STAGE_A(PG8_SA(1, 0), cA + kstep, 0, false); PG8_STAGE_B(PG8_SB(1, 1), cB + hstep + kstep);
    PG8_WAIT_V(6); PG8_BAR;
    for (;;) {
        const bool has_next = S.next(ui + 1, nxt);
        const char* nA = has_next ? S.abase(nxt) : cA; const char* nB = has_next ? S.bbase(nxt) : cB;
        if constexpr (GATHER) {
            if (has_next) {
#pragma unroll
                for (int h = 0; h < 2; ++h)
#pragma unroll
                    for (int i = 0; i < 2; ++i) ngvo[h][i] = S.goff(ui + 1, h * HALF + RA[i]) + CA[i];
            }
        }
        for (int t = 0; t < nt; t += 2) {
            const bool last = (t == nt - 2);
            const char* a1 = cA + (size_t)(t + 1) * kstep;
            const char* a2 = last ? nA : cA + (size_t)(t + 2) * kstep; const char* b2 = last ? nB : cB + (size_t)(t + 2) * kstep;
            const char* a3 = a2 + kstep; const char* b3 = b2 + kstep;
            PG8_LDB(B0, 0, 0); PG8_LDB(B1, 0, 1); PG8_SCHED; PG8_LDA(At, 0, 0); PG8_STAGE_A(PG8_SA(1, 1), a1, 1, false);
            PG8_WAIT_V(8); PG8_WAIT_L(0); PG8_BAR; PG8_MMA(0, 0, At, B0); PG8_MMA(0, 1, At, B1); PG8_BAR; PG8_SCHED;
            PG8_LDA(At, 0, 1); PG8_STAGE_B(PG8_SB(0, 0), b2); PG8_STAGE_B(PG8_SB(0, 1), b2 + hstep); PG8_STAGE_A(PG8_SA(0, 0), a2, 0, last);
            PG8_WAIT_V(8); PG8_WAIT_L(0); PG8_BAR; PG8_MMA(1, 0, At, B0); PG8_MMA(1, 1, At, B1); PG8_BAR; PG8_SCHED;
            PG8_LDB(B0, 1, 0); PG8_LDB(B1, 1, 1); PG8_SCHED; PG8_LDA(At, 1, 0); PG8_STAGE_A(PG8_SA(0, 1), a2, 1, last);
            PG8_WAIT_V(8); PG8_WAIT_L(0); PG8_BAR; PG8_MMA(0, 0, At, B0); PG8_MMA(0, 1, At, B1); PG8_BAR; PG8_SCHED;
            PG8_LDA(At, 1, 1); PG8_STAGE_B(PG8_SB(1, 0), b3); PG8_STAGE_B(PG8_SB(1, 1), b3 + hstep); PG8_STAGE_A(PG8_SA(1, 0), a3, 0, last);
            PG8_WAIT_V(8); PG8_WAIT_L(0); PG8_BAR; PG8_MMA(1, 0, At, B0); PG8_MMA(1, 1, At, B1); PG8_BAR; PG8_SCHED;
        }
        if constexpr (ALIGN_EPI) { if (wr == 0) PG8_BAR; }
        E(acc, cur, wr, wc, fr, fq);
        if (!has_next) break;
        if (!E.keep_acc(cur)) E.init(acc, nxt, wr, wc, fr, fq);
        cur = nxt; cA = nA; cB = nB; ++ui;
        if constexpr (GATHER) {
#pragma unroll
            for (int h = 0; h < 2; ++h)
#pragma unroll
                for (int i = 0; i < 2; ++i) gvo[h][i] = ngvo[h][i];
        }
        if constexpr (ALIGN_EPI) { if (wr == 1) PG8_BAR; }
    }
    PG8_WAIT_V(0);
    if constexpr (!ALIGN_EPI) { if (wr == 0) PG8_BAR; }
    PG8_BAR;
#undef PG8_SA
#undef PG8_SB
#undef PG8_STAGE2
#undef PG8_STAGE_A
#undef PG8_STAGE_B
#undef PG8_LDA
#undef PG8_LDB
#undef PG8_MMA
#undef PG8_WAIT_V
#undef PG8_WAIT_L
#undef PG8_BAR
#undef PG8_SCHED
}
}

struct SchedPlain {
    pg8::TileOrder T; const char* A; const char* Bt; size_t tstep;
    __device__ __forceinline__ bool next(int i, pg8::Unit& u) const { u.aux = 0; return T.tile(i, u.pm, u.pn); }
    __device__ __forceinline__ const char* abase(const pg8::Unit& u) const { return A + (size_t)u.pm * tstep; }
    __device__ __forceinline__ const char* bbase(const pg8::Unit& u) const { return Bt + (size_t)u.pn * tstep; }
    __device__ __forceinline__ unsigned goff(int, int) const { return 0u; }
};
struct SchedPair {
    pg8::TileOrder T; const char* A0; const char* A1; const char* B0; const char* B1; size_t tstep;
    __device__ __forceinline__ bool next(int i, pg8::Unit& u) const { u.aux = i & 1; return T.tile(i >> 1, u.pm, u.pn); }
    __device__ __forceinline__ const char* abase(const pg8::Unit& u) const { return (u.aux ? A1 : A0) + (size_t)u.pm * tstep; }
    __device__ __forceinline__ const char* bbase(const pg8::Unit& u) const { return (u.aux ? B1 : B0) + (size_t)u.pn * tstep; }
    __device__ __forceinline__ unsigned goff(int, int) const { return 0u; }
};
struct SchedMoe {
    const LAS int* tile_e; const LAS int* tile_mt; const LAS unsigned* gtab; int ntiles, nN, G, c;
    const char* A; const char* Bt; size_t a_tstep, b_estep, b_tstep; bool gather;
    __device__ __forceinline__ bool next(int i, pg8::Unit& u) const {
        int tile, pn;
        if (nN == 4) { const int x = c & 7, j = c >> 3, th = (ntiles + 1) >> 1, t = i * (G >> 3) + j; if (t >= th) return false; tile = (x >> 2) * th + t; if (tile >= ntiles) return false; pn = x & 3; }
        else { const int L = i * G + c; if (L >= ntiles * nN) return false; tile = L / nN; pn = L - tile * nN; }
        u.pm = tile; u.pn = pn; u.aux = tile_e[tile] | (tile_mt[tile] << 8) | (i << 16); return true; }
    __device__ __forceinline__ const char* abase(const pg8::Unit& u) const { return gather ? A : A + (size_t)u.pm * a_tstep; }
    __device__ __forceinline__ const char* bbase(const pg8::Unit& u) const { return Bt + (size_t)(u.aux & 255) * b_estep + (size_t)u.pn * b_tstep; }
    __device__ __forceinline__ unsigned goff(int ui, int row) const { return gtab[ui * 256 + row]; }
};

using pg8::Unit;
struct EpiInProj {
    static constexpr bool PERM = true;
    bf16* P; const float* rope;
    __device__ __forceinline__ bool keep_acc(const Unit&) const { return false; }
    __device__ __forceinline__ void init(f32x4 (&acc)[2][2][4][2], const Unit&, int, int, int, int) const {
#pragma unroll
        for (int a = 0; a < 2; ++a)
#pragma unroll
            for (int b = 0; b < 2; ++b)
#pragma unroll
                for (int m = 0; m < 4; ++m)
#pragma unroll
                    for (int n = 0; n < 2; ++n) acc[a][b][m][n] = (f32x4){0.f, 0.f, 0.f, 0.f};
    }
    __device__ __forceinline__ void operator()(f32x4 (&acc)[2][2][4][2], const Unit& u, int wr, int wc, int fr, int fq) const {
        const int row0 = u.pm * 256 + wr * 64 + fr, col0 = u.pn * 256 + wc * 32 + 8 * fq;
        const int kind = u.pn <= 3 ? 0 : (u.pn == 4 ? 1 : (u.pn < 18 ? 2 : 3));
        const bool do_rope = (kind <= 1) && ((wc & 1) == 0);
        const float sgn = fq == 0 ? -1.f : 1.f;
#pragma unroll
        for (int ai = 0; ai < 2; ++ai)
#pragma unroll
            for (int m = 0; m < 4; ++m) {
                const int row = row0 + ai * 128 + m * 16;
                bf16* rowp = P + (size_t)row * INC + col0;
                f32x4 c0 = {1.f, 1.f, 1.f, 1.f}, c1 = c0, s0 = {0.f, 0.f, 0.f, 0.f}, s1 = s0;
                if (do_rope) { const f32x4* rp = (const f32x4*)(rope + (size_t)(row & (SEQ - 1)) * 16); c0 = rp[0]; c1 = rp[1]; s0 = rp[2]; s1 = rp[3]; }
#pragma unroll
                for (int bj = 0; bj < 2; ++bj) {
                    f32x4 v0 = acc[ai][bj][m][0], v1 = acc[ai][bj][m][1];
                    if (do_rope) {
                        f32x4 p0, p1;
#pragma unroll
                        for (int e = 0; e < 4; ++e) { p0[e] = __shfl_xor(v0[e], 16); p1[e] = __shfl_xor(v1[e], 16); }
                        if (fq < 2) { v0 = v0 * c0 + p0 * s0 * sgn; v1 = v1 * c1 + p1 * s1 * sgn; }
                    }
                    if (kind == 0) { v0 = v0 * 0.125f; v1 = v1 * 0.125f; }
                    if (kind == 3) {
#pragma unroll
                        for (int e = 0; e < 4; ++e) { v0[e] = sigmoidf_(v0[e]); v1[e] = sigmoidf_(v1[e]); }
                    }
                    v4u w; w.x = pk2(v0[0], v0[1]); w.y = pk2(v0[2], v0[3]); w.z = pk2(v1[0], v1[1]); w.w = pk2(v1[2], v1[3]);
                    *(v4u*)(rowp + bj * 128) = w;
                }
            }
    }
};
struct EpiMerge {
    static constexpr bool PERM = true;
    const bf16* P; bf16* MG;
    __device__ __forceinline__ bool keep_acc(const Unit& u) const { return u.aux == 0; }
    __device__ __forceinline__ void init(f32x4 (&acc)[2][2][4][2], const Unit&, int, int, int, int) const {
#pragma unroll
        for (int a = 0; a < 2; ++a)
#pragma unroll
            for (int b = 0; b < 2; ++b)
#pragma unroll
                for (int m = 0; m < 4; ++m)
#pragma unroll
                    for (int n = 0; n < 2; ++n) acc[a][b][m][n] = (f32x4){0.f, 0.f, 0.f, 0.f};
    }
    __device__ __forceinline__ void operator()(f32x4 (&acc)[2][2][4][2], const Unit& u, int wr, int wc, int fr, int fq) const {
        const int row0 = u.pm * 256 + wr * 64 + fr, col0 = u.pn * 256 + wc * 32 + 8 * fq;
#pragma unroll
        for (int ai = 0; ai < 2; ++ai)
#pragma unroll
            for (int m = 0; m < 4; ++m) {
                const int row = row0 + ai * 128 + m * 16;
                const bf16* gp = P + (size_t)row * INC + col0;
                v4u gc[2], ga[2];
#pragma unroll
                for (int bj = 0; bj < 2; ++bj) { gc[bj] = *(const v4u*)(gp + C_GC + bj * 128); if (u.aux == 0) ga[bj] = *(const v4u*)(gp + C_GA + bj * 128); }
#pragma unroll
                for (int bj = 0; bj < 2; ++bj) {
                    float f2[8] = {bflo(gc[bj].x), bfhi(gc[bj].x), bflo(gc[bj].y), bfhi(gc[bj].y), bflo(gc[bj].z), bfhi(gc[bj].z), bflo(gc[bj].w), bfhi(gc[bj].w)};
#pragma unroll
                    for (int e = 0; e < 8; ++e) f2[e] = __builtin_fmaxf(f2[e], 1e-30f);
                    f32x4& v0 = acc[ai][bj][m][0]; f32x4& v1 = acc[ai][bj][m][1];
                    if (u.aux == 0) {
                        const float sa[8] = {bflo(ga[bj].x), bfhi(ga[bj].x), bflo(ga[bj].y), bfhi(ga[bj].y), bflo(ga[bj].z), bfhi(ga[bj].z), bflo(ga[bj].w), bfhi(ga[bj].w)};
#pragma unroll
                        for (int e = 0; e < 4; ++e) { v0[e] *= sa[e] * __builtin_amdgcn_rcpf(f2[e]); v1[e] *= sa[4 + e] * __builtin_amdgcn_rcpf(f2[4 + e]); }
                    } else {
#pragma unroll
                        for (int e = 0; e < 4; ++e) { v0[e] *= f2[e]; v1[e] *= f2[4 + e]; }
                        v4u w; w.x = pk2(v0[0], v0[1]); w.y = pk2(v0[2], v0[3]); w.z = pk2(v1[0], v1[1]); w.w = pk2(v1[2], v1[3]);
                        *(v4u*)(MG + (size_t)row * D + col0 + bj * 128) = w;
                    }
                }
            }
    }
};
struct EpiResHx {
    static constexpr bool PERM = true;
    const float* base; float* out; bf16* HX; const float* g; float* part;
    __device__ __forceinline__ bool keep_acc(const Unit&) const { return false; }
    __device__ __forceinline__ void init(f32x4 (&acc)[2][2][4][2], const Unit& u, int wr, int wc, int fr, int fq) const {
        const int row0 = u.pm * 256 + wr * 64 + fr, col0 = u.pn * 256 + wc * 32 + 8 * fq;
#pragma unroll
        for (int ai = 0; ai < 2; ++ai)
#pragma unroll
            for (int m = 0; m < 4; ++m) { const size_t off = (size_t)(row0 + ai * 128 + m * 16) * D + col0;
#pragma unroll
                for (int bj = 0; bj < 2; ++bj) { acc[ai][bj][m][0] = *(const f32x4*)(base + off + bj * 128); acc[ai][bj][m][1] = *(const f32x4*)(base + off + bj * 128 + 4); } }
    }
    __device__ __forceinline__ void operator()(f32x4 (&acc)[2][2][4][2], const Unit& u, int wr, int wc, int fr, int fq) const {
        const int row0 = u.pm * 256 + wr * 64 + fr, col0 = u.pn * 256 + wc * 32 + 8 * fq;
        f32x4 gv[2][2];
#pragma unroll
        for (int bj = 0; bj < 2; ++bj) { gv[bj][0] = *(const f32x4*)(g + col0 + bj * 128); gv[bj][1] = *(const f32x4*)(g + col0 + bj * 128 + 4); }
#pragma unroll
        for (int ai = 0; ai < 2; ++ai)
#pragma unroll
            for (int m = 0; m < 4; ++m) {
                const int row = row0 + ai * 128 + m * 16; const size_t off = (size_t)row * D + col0;
                float ssum = 0.f;
#pragma unroll
                for (int bj = 0; bj < 2; ++bj) {
                    const f32x4 v0 = acc[ai][bj][m][0], v1 = acc[ai][bj][m][1];
                    *(f32x4*)(out + off + bj * 128) = v0; *(f32x4*)(out + off + bj * 128 + 4) = v1;
                    ssum += (v0.x * v0.x + v0.y * v0.y) + (v0.z * v0.z + v0.w * v0.w) + (v1.x * v1.x + v1.y * v1.y) + (v1.z * v1.z + v1.w * v1.w);
                    const f32x4 h0 = v0 * gv[bj][0], h1 = v1 * gv[bj][1];
                    v4u w; w.x = pk2(h0.x, h0.y); w.y = pk2(h0.z, h0.w); w.z = pk2(h1.x, h1.y); w.w = pk2(h1.z, h1.w);
                    *(v4u*)(HX + off + bj * 128) = w;
                }
                ssum += __shfl_xor(ssum, 16); ssum += __shfl_xor(ssum, 32);
                if (fq == 0) part[(size_t)row * 32 + u.pn * 4 + wc] = ssum;
            }
    }
};
struct EpiMoeGU {
    static constexpr bool PERM = true;
    bf16* ACT; const float* wgt; const float* rsl; const LAS int* ltab;
    __device__ __forceinline__ bool keep_acc(const Unit&) const { return false; }
    __device__ __forceinline__ void init(f32x4 (&acc)[2][2][4][2], const Unit&, int, int, int, int) const {
#pragma unroll
        for (int a = 0; a < 2; ++a)
#pragma unroll
            for (int b = 0; b < 2; ++b)
#pragma unroll
                for (int m = 0; m < 4; ++m)
#pragma unroll
                    for (int n = 0; n < 2; ++n) acc[a][b][m][n] = (f32x4){0.f, 0.f, 0.f, 0.f};
    }
    __device__ __forceinline__ void operator()(f32x4 (&acc)[2][2][4][2], const Unit& u, int wr, int wc, int fr, int fq) const {
        const LAS int* lt = ltab + (u.aux >> 16) * 256;
        const int f0 = u.pn * 128 + wc * 32 + 8 * fq;
        float wrow[2][4], rrow[2][4];
#pragma unroll
        for (int ai = 0; ai < 2; ++ai)
#pragma unroll
            for (int m = 0; m < 4; ++m) { const int li = lt[ai * 128 + wr * 64 + m * 16 + fr]; const bool ok = li >= 0; wrow[ai][m] = ok ? wgt[li] : 0.f; rrow[ai][m] = ok ? rsl[li] : 0.f; }
#pragma unroll
        for (int ai = 0; ai < 2; ++ai)
#pragma unroll
            for (int m = 0; m < 4; ++m) {
                const int rl = ai * 128 + wr * 64 + m * 16 + fr;
                const float w = wrow[ai][m] * rrow[ai][m], rsd = rrow[ai][m];
                const f32x4 g0 = acc[ai][0][m][0] * rsd, g1 = acc[ai][0][m][1] * rsd, u0 = acc[ai][1][m][0], u1 = acc[ai][1][m][1];
                f32x4 a0, a1;
#pragma unroll
                for (int k = 0; k < 4; ++k) { a0[k] = g0[k] * sigmoidf_(g0[k]) * u0[k] * w; a1[k] = g1[k] * sigmoidf_(g1[k]) * u1[k] * w; }
                v4u o; o.x = pk2(a0[0], a0[1]); o.y = pk2(a0[2], a0[3]); o.z = pk2(a1[0], a1[1]); o.w = pk2(a1[2], a1[3]);
                *(v4u*)(ACT + (size_t)(u.pm * 256 + rl) * FF + f0) = o;
            }
    }
};
struct EpiMoeDown {
    static constexpr bool PERM = true;
    bf16* Y2; const int* tok; const LAS int* ltab;
    __device__ __forceinline__ bool keep_acc(const Unit&) const { return false; }
    __device__ __forceinline__ void init(f32x4 (&acc)[2][2][4][2], const Unit&, int, int, int, int) const {
#pragma unroll
        for (int a = 0; a < 2; ++a)
#pragma unroll
            for (int b = 0; b < 2; ++b)
#pragma unroll
                for (int m = 0; m < 4; ++m)
#pragma unroll
                    for (int n = 0; n < 2; ++n) acc[a][b][m][n] = (f32x4){0.f, 0.f, 0.f, 0.f};
    }
    __device__ __forceinline__ void operator()(f32x4 (&acc)[2][2][4][2], const Unit& u, int wr, int wc, int fr, int fq) const {
        const LAS int* lt = ltab + (u.aux >> 16) * 256;
        const int col0 = u.pn * 256 + wc * 32 + 8 * fq;
        int trow[2][4];
#pragma unroll
        for (int ai = 0; ai < 2; ++ai)
#pragma unroll
            for (int m = 0; m < 4; ++m) { const int li = lt[ai * 128 + wr * 64 + m * 16 + fr]; trow[ai][m] = li >= 0 ? tok[li] : -1; }
#pragma unroll
        for (int ai = 0; ai < 2; ++ai)
#pragma unroll
            for (int m = 0; m < 4; ++m) {
                const int t = trow[ai][m];
                if (t >= 0) {
                    bf16* yp = Y2 + (size_t)t * D + col0;
#pragma unroll
                    for (int bj = 0; bj < 2; ++bj) { const f32x4 v0 = acc[ai][bj][m][0], v1 = acc[ai][bj][m][1];
                        v4u w; w.x = pk2(v0[0], v0[1]); w.y = pk2(v0[2], v0[3]); w.z = pk2(v1[0], v1[1]); w.w = pk2(v1[2], v1[3]);
                        *(v4u*)(yp + bj * 128) = w; }
                }
            }
    }
};

#define XB_TMO      128
#define XB_XCNT(j)  (256  + 64 * (j))
#define XB_XSUB(j)  (1280 + 64 * (j))
#define XB_XGEN(j)  (2304 + 64 * (j))
#define XB_TOP      3328
#define XB_TOPGEN   3392
#define XCD_BAR_WORDS 3456
#define XB_SPIN_CAP (1u << 18)

__device__ __forceinline__ unsigned xb_ld(unsigned* p)              { return __hip_atomic_load((gu32*)p, __ATOMIC_RELAXED, __HIP_MEMORY_SCOPE_AGENT); }
__device__ __forceinline__ unsigned xb_add(unsigned* p, unsigned v) { return __hip_atomic_fetch_add((gu32*)p, v, __ATOMIC_RELAXED, __HIP_MEMORY_SCOPE_AGENT); }
__device__ __forceinline__ unsigned xb_xcc_id() { return (unsigned)__builtin_amdgcn_s_getreg((3 << 11) | 20) & 0xFu; }
#define XB_SPIN(cond, bar) do { unsigned _sp = 0; while (cond) { __builtin_amdgcn_s_sleep(1); \
    if ((++_sp & 255u) == 0u) { if (xb_ld(&(bar)[XB_TMO])) break; if (_sp > XB_SPIN_CAP) { (void)xb_add(&(bar)[XB_TMO], 1u); break; } } } } while (0)

struct XcdBarrier {
    unsigned* bar; unsigned x;
    volatile LAS unsigned* st;
};
__device__ __forceinline__ XcdBarrier xcd_barrier_post(unsigned* bar, volatile LAS unsigned* st) {
    XcdBarrier b; b.bar = bar; b.x = xb_xcc_id(); b.st = st;
    if (threadIdx.x == 0) (void)xb_add(&bar[XB_XCNT(b.x)], 1u);
    return b;
}
__device__ __forceinline__ void xcd_barrier_complete(unsigned* bar, unsigned x, unsigned& nloc, unsigned& nx) {
    const unsigned G = gridDim.x * gridDim.y * gridDim.z;
    unsigned sum, cnt, mine, sp = 0u;
    for (;;) {
        sum = 0u; cnt = 0u; mine = 0u;
#pragma unroll
        for (unsigned j = 0; j < 16; ++j) { const unsigned c = xb_ld(&bar[XB_XCNT(j)]); sum += c; cnt += (c > 0u) ? 1u : 0u; mine = (j == x) ? c : mine; }
        if (sum == G) break;
        __builtin_amdgcn_s_sleep(1);
        if ((++sp & 255u) == 0u) { if (xb_ld(&bar[XB_TMO])) break; if (sp > XB_SPIN_CAP) { (void)xb_add(&bar[XB_TMO], 1u); break; } }
    }
    nloc = mine > 0u ? mine : 1u; nx = cnt > 0u ? cnt : 1u;
}
__device__ __forceinline__ void xcd_barrier(const XcdBarrier& b) {
    asm volatile("s_waitcnt vmcnt(0)" ::: "memory");
    __syncthreads();
    if (threadIdx.x == 0) {
        unsigned* bar = b.bar; unsigned bx_ = b.x;
        asm volatile("" : "+s"(bar), "+s"(bx_));
        __builtin_amdgcn_s_waitcnt(0);
        unsigned nloc = b.st[0], nx = b.st[1];
        if (nloc == 0u) { xcd_barrier_complete(bar, bx_, nloc, nx); b.st[0] = nloc; b.st[1] = nx; }
        const unsigned old = xb_add(&bar[XB_XSUB(bx_)], 1u);
        const unsigned gen = old / nloc;
        if (old + 1u == (gen + 1u) * nloc) {
            __builtin_amdgcn_fence(__ATOMIC_RELEASE, "agent");
            asm volatile("s_waitcnt vmcnt(0)" ::: "memory");
            const unsigned og = xb_add(&bar[XB_TOP], 1u);
            const unsigned tg = og / nx;
            if (og + 1u == (tg + 1u) * nx) xb_add(&bar[XB_TOPGEN], 1u);
            else XB_SPIN(xb_ld(&bar[XB_TOPGEN]) == tg, bar);
            __builtin_amdgcn_fence(__ATOMIC_ACQUIRE, "agent");
            xb_add(&bar[XB_XGEN(bx_)], 1u);
            asm volatile("s_waitcnt vmcnt(0)" ::: "memory");
        } else {
            XB_SPIN(xb_ld(&bar[XB_XGEN(bx_)]) == gen, bar);
            __builtin_amdgcn_fence(__ATOMIC_ACQUIRE, "agent");
            asm volatile("s_waitcnt vmcnt(0)" ::: "memory");
        }
    }
    __syncthreads();
}

__device__ __forceinline__ float wave_sum(float v) {
#pragma unroll
    for (int o = 1; o < 64; o <<= 1) v += __shfl_xor(v, o);
    return v;
}
struct Args { const float* in[17]; float* out; unsigned char* ws; int ph_lo, ph_hi, li, pad; };
struct CvtItem { const float* W; bf16* WT; int K, N, k0, n0, drow0; };
enum { CVT_WIN = 0, CVT_S = 1, CVT_GU = 2, CVT_B = 3 };
__device__ __forceinline__ int cvt_count(int list) { return list == CVT_WIN ? 64 * 136 : list == CVT_S ? (1024 + 1024 + 2048) : list == CVT_GU ? 2 * 16384 : 16384; }
__device__ __forceinline__ CvtItem cvt_decode(const Args& a, int list, int l, int it) {
    CvtItem c; unsigned char* wl = a.ws + WS_WL + (size_t)l * WL_STRIDE;
    if (list == CVT_WIN) { const int kb = it / 136, nb = it - kb * 136; c.W = a.in[2] + (size_t)l * D * INC; c.WT = (bf16*)(wl + WL_IN); c.K = D; c.N = INC; c.k0 = 32 * kb; c.n0 = 64 * nb; c.drow0 = c.n0; return c; }
    if (list == CVT_B) { const int e = it >> 9, q = it & 511, kb = q >> 5, nb = q & 31; c.W = a.in[15] + ((size_t)l * NE + e) * FF * D; c.WT = (bf16*)(wl + WL_D) + (size_t)e * D * FF; c.K = FF; c.N = D; c.k0 = 32 * kb; c.n0 = 64 * nb; c.drow0 = c.n0; return c; }
    int r = it;
    if (list == CVT_S) {
    if (r < 1024) { c.W = a.in[4] + (size_t)l * 1024 * D; c.WT = (bf16*)(wl + WL_A); c.K = 1024; c.N = D; c.k0 = 32 * (r >> 5); c.n0 = 64 * (r & 31); c.drow0 = c.n0; return c; } r -= 1024;
    if (r < 1024) { c.W = a.in[6] + (size_t)l * 1024 * D; c.WT = (bf16*)(wl + WL_C); c.K = 1024; c.N = D; c.k0 = 32 * (r >> 5); c.n0 = 64 * (r & 31); c.drow0 = c.n0; return c; } r -= 1024;
    { c.W = a.in[7] + (size_t)l * D * D; c.WT = (bf16*)(wl + WL_O); c.K = D; c.N = D; c.k0 = 32 * (r >> 5); c.n0 = 64 * (r & 31); c.drow0 = c.n0; return c; }
    }
    const int up = r >= 16384; if (up) r -= 16384;
    const int e = r >> 9, q = r & 511, kb = q >> 3, nb = q & 7;
    c.W = a.in[up ? 14 : 13] + ((size_t)l * NE + e) * D * FF; c.WT = (bf16*)(wl + WL_GU) + (size_t)e * 1024 * D; c.K = D; c.N = FF; c.k0 = 32 * kb; c.n0 = 64 * nb;
    c.drow0 = (c.n0 >> 7) * 256 + (c.n0 & 127) + (up ? 128 : 0); return c;
}
__device__ __forceinline__ void cvt_load(f32x4 (&v)[8], const CvtItem& c, int lane) {
    const float* p = c.W + (size_t)(c.k0 + (lane >> 4)) * c.N + c.n0 + (lane & 15) * 4;
#pragma unroll
    for (int i = 0; i < 8; ++i) v[i] = __builtin_nontemporal_load((const f32x4*)(p + (size_t)(4 * i) * c.N));
}
__device__ __forceinline__ void cvt_emit(const f32x4 (&v)[8], const CvtItem& cur, LAS float* scr, int lane) {
    const int lr = lane >> 4, lc = (lane & 15) * 4, c8 = (lane & 3) * 8, nr = lane >> 2;
#pragma unroll
    for (int i = 0; i < 8; ++i) { LAS float* d = scr + (4 * i + lr) * 65 + lc; d[0] = v[i].x; d[1] = v[i].y; d[2] = v[i].z; d[3] = v[i].w; }
    LDS_WAIT(); asm volatile("" ::: "memory");
#pragma unroll
    for (int jj = 0; jj < 4; ++jj) { const int n = nr + 16 * jj; const LAS float* s = scr + c8 * 65 + n;
        v4u o; o.x = pk2(s[0 * 65], s[1 * 65]); o.y = pk2(s[2 * 65], s[3 * 65]); o.z = pk2(s[4 * 65], s[5 * 65]); o.w = pk2(s[6 * 65], s[7 * 65]);
        __builtin_nontemporal_store(o, (GAS v4u*)(cur.WT + (size_t)(cur.drow0 + n) * cur.K + cur.k0 + c8)); }
    LDS_WAIT(); asm volatile("" ::: "memory");
}
__device__ __forceinline__ void cvt_run(const Args& a, int list, int l, int w, int nw, LAS float* scr, int lane, int it_lo = 0, int it_hi = 1 << 30, int pace = 0) {
    const int T = cvt_count(list) < it_hi ? cvt_count(list) : it_hi;
    int it = it_lo + w;
    CvtItem cA, cB, cC; f32x4 vA[8], vB[8], vC[8];
    bool hA = it < T, hB, hC;
    if (hA) { cA = cvt_decode(a, list, l, it); cvt_load(vA, cA, lane); } it += nw;
    hB = it < T; if (hB) { cB = cvt_decode(a, list, l, it); cvt_load(vB, cB, lane); } it += nw;
    while (hA) {
        hC = it < T; if (hC) { cC = cvt_decode(a, list, l, it); cvt_load(vC, cC, lane); } it += nw;
        cvt_emit(vA, cA, scr, lane); for (int z = 0; z < pace; ++z) __builtin_amdgcn_s_sleep(32);
        if (!hB) break;
        hA = it < T; if (hA) { cA = cvt_decode(a, list, l, it); cvt_load(vA, cA, lane); } it += nw;
        cvt_emit(vB, cB, scr, lane); for (int z = 0; z < pace; ++z) __builtin_amdgcn_s_sleep(32);
        if (!hC) break;
        hB = it < T; if (hB) { cB = cvt_decode(a, list, l, it); cvt_load(vB, cB, lane); } it += nw;
        cvt_emit(vC, cC, scr, lane); for (int z = 0; z < pace; ++z) __builtin_amdgcn_s_sleep(32);
    }
}
__device__ __forceinline__ void norm_row(const float* xrow, const bf16* y0, const bf16* y1, float* xo, const float* g, bf16* hb, float* of, int lane) {
    f32x4 v[8]; float s = 0.f;
#pragma unroll
    for (int j = 0; j < 8; ++j) { v[j] = ((const f32x4*)xrow)[lane + 64 * j]; }
    if (y0) {
        v2u a0[8], a1[8];
#pragma unroll
        for (int j = 0; j < 8; ++j) { a0[j] = ((const v2u*)y0)[lane + 64 * j]; a1[j] = ((const v2u*)y1)[lane + 64 * j]; }
#pragma unroll
        for (int j = 0; j < 8; ++j) { v[j].x += bflo(a0[j].x); v[j].y += bfhi(a0[j].x); v[j].z += bflo(a0[j].y); v[j].w += bfhi(a0[j].y); }
#pragma unroll
        for (int j = 0; j < 8; ++j) { v[j].x += bflo(a1[j].x); v[j].y += bfhi(a1[j].x); v[j].z += bflo(a1[j].y); v[j].w += bfhi(a1[j].y); }
    }
#pragma unroll
    for (int j = 0; j < 8; ++j) s += (v[j].x * v[j].x + v[j].y * v[j].y) + (v[j].z * v[j].z + v[j].w * v[j].w);
    if (xo) {
#pragma unroll
        for (int j = 0; j < 8; ++j) ((f32x4*)xo)[lane + 64 * j] = v[j];
    }
    const float rstd = 1.0f / sqrtf(wave_sum(s) * (1.f / D) + NORM_EPS);
#pragma unroll
    for (int j = 0; j < 8; ++j) {
        const f32x4 gg = ((const f32x4*)g)[lane + 64 * j];
        const f32x4 o = v[j] * rstd * gg;
        if (hb) { v2u w; w.x = pk2(o.x, o.y); w.y = pk2(o.z, o.w); ((v2u*)hb)[lane + 64 * j] = w; }
        else ((f32x4*)of)[lane + 64 * j] = o;
    }
}


__device__ __forceinline__ void phase_prologue(const Args& a, LAS unsigned char* lds, int vcu, int G, int wave, int lane) {
    unsigned char* ws = a.ws;
    LAS float* scr = (LAS float*)(lds + wave * 16384);
    const int gw = vcu * NWAVES + wave, NGW = G * NWAVES;
    cvt_run(a, CVT_WIN, 0, gw, NGW, scr, lane); cvt_run(a, CVT_S, 0, gw, NGW, scr, lane);
    const int gt = gw * 64 + lane, NGT = NGW * 64;
    for (int idx = gt; idx < DEPTH * 48 * D; idx += NGT) {
        const int l = idx / (48 * D), rem = idx - l * 48 * D, n = rem / D, k = rem - n * D;
        float w = 0.f; if (n < 4) w = a.in[9][((size_t)l * D + k) * 4 + n]; else if (n < 36) w = a.in[11][((size_t)l * D + k) * 32 + (n - 4)];
        const unsigned hi = f2bf(w); const float lo = w - __builtin_bit_cast(float, hi << 16);
        bf16* wr = (bf16*)(ws + WS_WL + (size_t)l * WL_STRIDE + WL_R);
        wr[n * D + k] = (bf16)hi; wr[48 * D + n * D + k] = (bf16)f2bf(lo);
    }
    for (int idx = gt; idx < SEQ * 8; idx += NGT) {
        const int pos = idx >> 3, i = idx & 7;
        const float inv = i == 0 ? 1.0f : i == 1 ? 0x1.8d275ep-3f : i == 2 ? 0x1.341190p-5f : i == 3 ? 0x1.ddee9cp-8f : i == 4 ? 0x1.72ba44p-10f : i == 5 ? 0x1.1f91f0p-12f : i == 6 ? 0x1.be2188p-15f : 0x1.5a0f4ep-17f;
        const float ang = (float)pos * inv;
        const double ad = (double)ang, kq = __builtin_rint(ad * 0.63661977236758134308);
        const double rr = __builtin_fma(-kq, 1.5707963267948966192, ad) - kq * 6.123233995736766e-17, r2 = rr * rr;
        const double sp = rr * (1.0 + r2 * (-1.0 / 6 + r2 * (1.0 / 120 + r2 * (-1.0 / 5040 + r2 * (1.0 / 362880 + r2 * (-1.0 / 39916800 + r2 * (1.0 / 6227020800.0)))))));
        const double cp = 1.0 + r2 * (-0.5 + r2 * (1.0 / 24 + r2 * (-1.0 / 720 + r2 * (1.0 / 40320 + r2 * (-1.0 / 3628800 + r2 * (1.0 / 479001600.0 + r2 * (-1.0 / 87178291200.0)))))));
        const int qd = (int)kq & 3;
        const double sn = qd == 0 ? sp : qd == 1 ? cp : qd == 2 ? -sp : -cp, cs = qd == 0 ? cp : qd == 1 ? -sp : qd == 2 ? -cp : sp;
        float* rp = (float*)(ws + WS_ROPE) + (size_t)pos * 16;
        rp[i] = (float)cs; rp[8 + i] = (float)sn;
    }
    for (int m = gw; m < M; m += NGW) norm_row(a.in[0] + (size_t)m * D, nullptr, nullptr, nullptr, a.in[1], (bf16*)(ws + WS_H) + (size_t)m * D, nullptr, lane);
}

constexpr int KS_STRIDE = 144, VT_OFF = 256 * KS_STRIDE, VT_STRIDE = 520;
__device__ __forceinline__ int crow(int r, int hi) { return (r & 3) + 8 * (r >> 2) + 4 * hi; }
__device__ __forceinline__ void attn_side_work(const Args& a, int l, LAS unsigned char* lds, int G, int vcu, int wave, int lane, int gu_lo);
__device__ __forceinline__ void phase_attn_conv(const Args& a, int l, LAS unsigned char* lds, int G, int vcu, int tid, int wave, int lane, int gu_lo) {
#define side_work() attn_side_work(a, l, lds, G, vcu, wave, lane, gu_lo)
    unsigned char* ws = a.ws;
    const bf16* P = (const bf16*)(ws + WS_P);
    bf16* AO = (bf16*)(ws + WS_AO);
    const float* sinks = a.in[3] + l * 16;
    const int j = lane & 31, h = lane >> 5;
    constexpr float LOG2E = 1.4426950408889634f;
    {   const int unit = blockIdx.x;
        const int qb = unit & 31, kvh = (unit >> 5) & 3, b = unit >> 7;
        const int q0 = qb * 128; const size_t rowbase = (size_t)b * SEQ;
#pragma unroll
        for (int it = 0; it < 4; ++it) {
            const int idx = it * 512 + tid, kl = idx >> 3, ch = idx & 7, pos = q0 - 128 + kl;
            v4u kv = {0u, 0u, 0u, 0u}, vv = kv;
            if (pos >= 0) { const bf16* src = P + (rowbase + pos) * INC + kvh * 64 + ch * 8; kv = *(const v4u*)(src + C_K); vv = *(const v4u*)(src + C_V); }
            *(LAS v4u*)(lds + kl * KS_STRIDE + ch * 16) = kv;
            LAS unsigned short* vt = (LAS unsigned short*)(lds + VT_OFF + (ch * 8) * VT_STRIDE + kl * 2);
            vt[0 * (VT_STRIDE / 2)] = (unsigned short)(vv.x & 0xffffu); vt[1 * (VT_STRIDE / 2)] = (unsigned short)(vv.x >> 16);
            vt[2 * (VT_STRIDE / 2)] = (unsigned short)(vv.y & 0xffffu); vt[3 * (VT_STRIDE / 2)] = (unsigned short)(vv.y >> 16);
            vt[4 * (VT_STRIDE / 2)] = (unsigned short)(vv.z & 0xffffu); vt[5 * (VT_STRIDE / 2)] = (unsigned short)(vv.z >> 16);
            vt[6 * (VT_STRIDE / 2)] = (unsigned short)(vv.w & 0xffffu); vt[7 * (VT_STRIDE / 2)] = (unsigned short)(vv.w >> 16);
        }
        __syncthreads();
        if (wave >= 4) side_work();
        else
#pragma unroll 1
        for (int tk = 0; tk < 4; ++tk) {
            const int task = wave + 4 * tk, hql = task >> 2, sub = task & 3, r0 = sub * 32, head = kvh * 4 + hql;
            const bf16* qrow = P + (rowbase + q0 + r0 + j) * INC + C_Q + head * 64 + h * 8;
            bf16x8 qf[4];
#pragma unroll
            for (int c = 0; c < 4; ++c) qf[c] = *(const bf16x8*)(qrow + 16 * c);
            f32x16 s[5];
#pragma unroll
            for (int kbi = 0; kbi < 5; ++kbi) {
                const int kl0 = 32 * (sub + kbi);
                f32x16 acc = {0.f, 0.f, 0.f, 0.f, 0.f, 0.f, 0.f, 0.f, 0.f, 0.f, 0.f, 0.f, 0.f, 0.f, 0.f, 0.f};
#pragma unroll
                for (int c = 0; c < 4; ++c) {
                    const bf16x8 kf = *(const LAS bf16x8*)(lds + (kl0 + j) * KS_STRIDE + (16 * c + 8 * h) * 2);
                    acc = __builtin_amdgcn_mfma_f32_32x32x16_bf16(kf, qf[c], acc, 0, 0, 0);
                }
                s[kbi] = acc;
                __builtin_amdgcn_sched_barrier(0);
            }
            const float sink = sinks[head] * LOG2E;
            float mx = sink;
#pragma unroll
            for (int kbi = 0; kbi < 5; ++kbi) {
                const int base = (qb == 0 && sub + kbi < 4) ? -4096 : (j + 128 - 32 * kbi - 4 * h);
#pragma unroll
                for (int i = 0; i < 16; ++i) {
                    const int dd = base - ((i & 3) + 8 * (i >> 2)), tt = min(dd, 127 - dd);
                    const float pen = __builtin_bit_cast(float, 0x7f800000u | ((unsigned)(tt >> 31) & 0x80000000u));
                    const float v = __builtin_fminf(s[kbi][i] * LOG2E, pen); s[kbi][i] = v; mx = __builtin_fmaxf(mx, v);
                }
            }
            mx = __builtin_fmaxf(mx, __shfl_xor(mx, 32));
            float lsum = 0.f;
#pragma unroll
            for (int kbi = 0; kbi < 5; ++kbi)
#pragma unroll
                for (int i = 0; i < 16; ++i) { const float p = __builtin_amdgcn_exp2f(s[kbi][i] - mx); s[kbi][i] = p; lsum += p; }
            lsum += __shfl_xor(lsum, 32);
            lsum += __builtin_amdgcn_exp2f(sink - mx);
            f32x16 o[2];
#pragma unroll
            for (int db = 0; db < 2; ++db) o[db] = (f32x16){0.f, 0.f, 0.f, 0.f, 0.f, 0.f, 0.f, 0.f, 0.f, 0.f, 0.f, 0.f, 0.f, 0.f, 0.f, 0.f};
#pragma unroll
            for (int kbi = 0; kbi < 5; ++kbi)
#pragma unroll
                for (int st = 0; st < 2; ++st) {
                    v4u pw; pw.x = pk2i(s[kbi][8 * st + 0], s[kbi][8 * st + 1]); pw.y = pk2i(s[kbi][8 * st + 2], s[kbi][8 * st + 3]);
                    pw.z = pk2i(s[kbi][8 * st + 4], s[kbi][8 * st + 5]); pw.w = pk2i(s[kbi][8 * st + 6], s[kbi][8 * st + 7]);
                    const bf16x8 pf = __builtin_bit_cast(bf16x8, pw);
#pragma unroll
                    for (int db = 0; db < 2; ++db) {
                        const int addr = VT_OFF + (32 * db + j) * VT_STRIDE + (32 * (sub + kbi) + 16 * st + 4 * h) * 2;
                        const s16x4 lo = *(const LAS s16x4*)(lds + addr), hi = *(const LAS s16x4*)(lds + addr + 16);
                        const bf16x8 vf = __builtin_shufflevector(lo, hi, 0, 1, 2, 3, 4, 5, 6, 7);
                        o[db] = __builtin_amdgcn_mfma_f32_32x32x16_bf16(vf, pf, o[db], 0, 0, 0);
                    }
                    __builtin_amdgcn_sched_barrier(0);
                }
            const float inv = 1.0f / lsum;
            bf16* orow = AO + (rowbase + q0 + r0 + j) * 1024 + head * 64 + 4 * h;
#pragma unroll
            for (int db = 0; db < 2; ++db)
#pragma unroll
                for (int g = 0; g < 4; ++g) {
                    v2u w; w.x = pk2i(o[db][4 * g + 0] * inv, o[db][4 * g + 1] * inv); w.y = pk2i(o[db][4 * g + 2] * inv, o[db][4 * g + 3] * inv);
                    *(v2u*)(orow + 32 * db + 8 * g) = w;
                }
        }
        __syncthreads();
    }
}
__device__ __forceinline__ void attn_side_work(const Args& a, int l, LAS unsigned char* lds, int G, int vcu, int wave, int lane_in, int gu_lo) {
    int lane = lane_in; asm volatile("" : "+v"(lane));
    unsigned char* ws = a.ws;
    const bf16* P = (const bf16*)(ws + WS_P);
    bf16* CV = (bf16*)(ws + WS_CV);
    const float* cw = a.in[5] + (size_t)l * 3 * 1024;
    for (int it = blockIdx.x * 256 + (wave - 4) * 64 + lane; it < 1024 * 128; it += G * 256) {
        const int ch = it & 127, t0 = (it >> 7) * 8, c0 = ch * 8;
        float w0[8], w1[8], w2[8], u1[8], u2[8];
#pragma unroll
        for (int e = 0; e < 8; ++e) { w0[e] = cw[c0 + e]; w1[e] = cw[1024 + c0 + e]; w2[e] = cw[2048 + c0 + e]; u1[e] = 0.f; u2[e] = 0.f; }
        if ((t0 & (SEQ - 1)) != 0) {
            const bf16* p2 = P + (size_t)(t0 - 2) * INC + c0; const bf16* p1 = p2 + INC;
            const v4u c2 = *(const v4u*)(p2 + C_CC), x2 = *(const v4u*)(p2 + C_CX), c1 = *(const v4u*)(p1 + C_CC), x1 = *(const v4u*)(p1 + C_CX);
            u2[0] = bflo(c2.x) * bflo(x2.x); u2[1] = bfhi(c2.x) * bfhi(x2.x); u2[2] = bflo(c2.y) * bflo(x2.y); u2[3] = bfhi(c2.y) * bfhi(x2.y);
            u2[4] = bflo(c2.z) * bflo(x2.z); u2[5] = bfhi(c2.z) * bfhi(x2.z); u2[6] = bflo(c2.w) * bflo(x2.w); u2[7] = bfhi(c2.w) * bfhi(x2.w);
            u1[0] = bflo(c1.x) * bflo(x1.x); u1[1] = bfhi(c1.x) * bfhi(x1.x); u1[2] = bflo(c1.y) * bflo(x1.y); u1[3] = bfhi(c1.y) * bfhi(x1.y);
            u1[4] = bflo(c1.z) * bflo(x1.z); u1[5] = bfhi(c1.z) * bfhi(x1.z); u1[6] = bflo(c1.w) * bflo(x1.w); u1[7] = bfhi(c1.w) * bfhi(x1.w);
        }
#pragma unroll
        for (int t = 0; t < 8; ++t) {
            const bf16* pp = P + (size_t)(t0 + t) * INC + c0;
            const v4u cc = *(const v4u*)(pp + C_CC), cx = *(const v4u*)(pp + C_CX), cb = *(const v4u*)(pp + C_CB);
            float u0[8], bb[8], y[8];
            u0[0] = bflo(cc.x) * bflo(cx.x); u0[1] = bfhi(cc.x) * bfhi(cx.x); u0[2] = bflo(cc.y) * bflo(cx.y); u0[3] = bfhi(cc.y) * bfhi(cx.y);
            u0[4] = bflo(cc.z) * bflo(cx.z); u0[5] = bfhi(cc.z) * bfhi(cx.z); u0[6] = bflo(cc.w) * bflo(cx.w); u0[7] = bfhi(cc.w) * bfhi(cx.w);
            bb[0] = bflo(cb.x); bb[1] = bfhi(cb.x); bb[2] = bflo(cb.y); bb[3] = bfhi(cb.y); bb[4] = bflo(cb.z); bb[5] = bfhi(cb.z); bb[6] = bflo(cb.w); bb[7] = bfhi(cb.w);
#pragma unroll
            for (int e = 0; e < 8; ++e) { y[e] = bb[e] * (w0[e] * u2[e] + w1[e] * u1[e] + w2[e] * u0[e]); u2[e] = u1[e]; u1[e] = u0[e]; }
            v4u o; o.x = pk2(y[0], y[1]); o.y = pk2(y[2], y[3]); o.z = pk2(y[4], y[5]); o.w = pk2(y[6], y[7]);
            *(v4u*)(CV + (size_t)(t0 + t) * 1024 + c0) = o;
        }
    }
    cvt_run(a, CVT_GU, l, vcu * 4 + (wave - 4), G * 4, (LAS float*)(lds + 81920 + (wave - 4) * 8704), lane, gu_lo, GU_SPLIT2);
}

__device__ __forceinline__ void phase_norm_router(const Args& a, int l, LAS unsigned char* lds, int G, int vcu, int tid, int wave, int lane, int bank) {
    unsigned char* ws = a.ws;
    const bf16* HX = (const bf16*)(ws + WS_H);
    const float* part = (const float*)(ws + WS_PART);
    const bf16* Wh = (const bf16*)(ws + WS_WL + (size_t)l * WL_STRIDE + WL_R); const bf16* Wl = Wh + 48 * D;
    const float* bg = a.in[10] + l * 4; const float* br = a.in[12] + l * 32;
    unsigned* cnt = (unsigned*)(ws + WS_CTL) + CW_CNT + l * 256 + bank * 512 + (blockIdx.x & 7) * 32;
    int* tok = (int*)(ws + WS_TOK); float* wgt = (float*)(ws + WS_WGT); float* rsl = (float*)(ws + WS_RSL);
    LAS float* red = (LAS float*)lds;
    LAS float* lg = (LAS float*)(lds + 49152);
    LAS float* rs = (LAS float*)(lds + 49152 + 6144);
    const int r = lane & 15, q = lane >> 4;
    {   const int blk = blockIdx.x;
        const int row0 = blk * 32;
        if (tid < 32) { const f32x4* pp = (const f32x4*)(part + (size_t)(row0 + tid) * 32); float t = 0.f;
#pragma unroll
            for (int i = 0; i < 8; ++i) { const f32x4 v = pp[i]; t += (v.x + v.y) + (v.z + v.w); }
            rs[tid] = 1.0f / sqrtf(t * (1.f / D) + NORM_EPS); }
        bf16x8 xa[2][8];
#pragma unroll
        for (int rg = 0; rg < 2; ++rg)
#pragma unroll
            for (int jj = 0; jj < 8; ++jj) xa[rg][jj] = *(const bf16x8*)(HX + (size_t)(row0 + 16 * rg + r) * D + 256 * wave + 32 * jj + 8 * q);
        f32x4 acc[2][3];
#pragma unroll
        for (int rg = 0; rg < 2; ++rg)
#pragma unroll
            for (int cb = 0; cb < 3; ++cb) acc[rg][cb] = (f32x4){0.f, 0.f, 0.f, 0.f};
#pragma unroll
        for (int hb = 0; hb < 8 / RB; ++hb) {
            bf16x8 wh[RB][3], wl[RB][3];
#pragma unroll
            for (int j2 = 0; j2 < RB; ++j2)
#pragma unroll
                for (int cb = 0; cb < 3; ++cb) { const size_t o = (size_t)(16 * cb + r) * D + 256 * wave + 32 * (RB * hb + j2) + 8 * q; wh[j2][cb] = *(const bf16x8*)(Wh + o); wl[j2][cb] = *(const bf16x8*)(Wl + o); }
            __builtin_amdgcn_sched_barrier(0);
#pragma unroll
            for (int j2 = 0; j2 < RB; ++j2)
#pragma unroll
                for (int cb = 0; cb < 3; ++cb)
#pragma unroll
                    for (int rg = 0; rg < 2; ++rg) {
                        acc[rg][cb] = __builtin_amdgcn_mfma_f32_16x16x32_bf16(wh[j2][cb], xa[rg][RB * hb + j2], acc[rg][cb], 0, 0, 0);
                        acc[rg][cb] = __builtin_amdgcn_mfma_f32_16x16x32_bf16(wl[j2][cb], xa[rg][RB * hb + j2], acc[rg][cb], 0, 0, 0);
                    }
            __builtin_amdgcn_sched_barrier(0);
        }
#pragma unroll
        for (int rg = 0; rg < 2; ++rg)
#pragma unroll
            for (int cb = 0; cb < 3; ++cb) *(LAS f32x4*)(red + (wave * 32 + 16 * rg + r) * 48 + 16 * cb + 4 * q) = acc[rg][cb];
        __syncthreads();
        for (int idx = tid; idx < 32 * 48; idx += 512) { float t = 0.f;
#pragma unroll
            for (int w = 0; w < 8; ++w) t += red[w * 1536 + idx];
            lg[idx] = t; }
        __syncthreads();
        if (wave >= 1) { int ln = lane; asm volatile("" : "+v"(ln)); cvt_run(a, CVT_GU, l, vcu * 7 + (wave - 1), G * 7, (LAS float*)(lds + 65536 + (wave - 1) * 8704), ln, GU_SPLIT2, 1 << 30); }
        if (tid < 32) {
            const float rsd = rs[tid]; const LAS float* lr = lg + tid * 48;
            float gl0 = lr[0] * rsd + bg[0], gl1 = lr[1] * rsd + bg[1], gl2 = lr[2] * rsd + bg[2], gl3 = lr[3] * rsd + bg[3];
            int gi = 0; float gm = gl0;
            if (gl1 > gm) { gm = gl1; gi = 1; } if (gl2 > gm) { gm = gl2; gi = 2; } if (gl3 > gm) { gm = gl3; gi = 3; }
            const float gw = 1.0f / (__expf(gl0 - gm) + __expf(gl1 - gm) + __expf(gl2 - gm) + __expf(gl3 - gm));
            float sv[8];
#pragma unroll
            for (int e = 0; e < 8; ++e) sv[e] = lr[4 + gi * 8 + e] * rsd + br[gi * 8 + e];
            int i1 = 0; float m1 = sv[0];
#pragma unroll
            for (int e = 1; e < 8; ++e) if (sv[e] > m1) { m1 = sv[e]; i1 = e; }
            int i2 = (i1 + 1) & 7; float m2 = -INFINITY;
#pragma unroll
            for (int e = 0; e < 8; ++e) if (e != i1 && sv[e] > m2) { m2 = sv[e]; i2 = e; }
            const float p2 = __expf(m2 - m1), w1 = gw / (1.0f + p2), w2 = gw * p2 / (1.0f + p2);
            const int e1 = gi * 8 + i1, e2 = gi * 8 + i2, token = row0 + tid;
            const unsigned pos1 = __hip_atomic_fetch_add(cnt + e1, 1u, RLX_AGENT), pos2 = __hip_atomic_fetch_add(cnt + e2, 1u, RLX_AGENT);
            const int li1 = e1 * M + (blockIdx.x & 7) * SHARD_CAP + (int)pos1, li2 = e2 * M + (blockIdx.x & 7) * SHARD_CAP + (int)pos2;
            tok[li1] = token * 2; wgt[li1] = w1; rsl[li1] = rsd;
            tok[li2] = token * 2 + 1; wgt[li2] = w2; rsl[li2] = rsd;
        }
        __syncthreads();
    }
}

__device__ __forceinline__ int slot_index(const LAS int* sp, int e, int pos) {
    int sh = 0;
#pragma unroll
    for (int k = 1; k < NSHARD; ++k) sh += (pos >= sp[e * 9 + k]) ? 1 : 0;
    return e * M + sh * SHARD_CAP + pos - sp[e * 9 + sh];
}
__device__ __forceinline__ int moe_tables(const Args& a, int l, LAS unsigned char* lds, int tid) {
    LAS int* tile_e = (LAS int*)(lds + TILE_OFF); LAS int* tile_mt = tile_e + 128; LAS int* lcnt = tile_e + 256; LAS int* lnt = tile_e + 288;
    const unsigned* cnt = (const unsigned*)(a.ws + WS_CTL) + CW_CNT + l * 256;
    if (tid < 64) {
        LAS int* sp = tile_e + 320;
        int c = 0;
        if (tid < 32) { unsigned cs[NSHARD];
#pragma unroll
            for (int sh = 0; sh < NSHARD; ++sh) cs[sh] = __hip_atomic_load(cnt + sh * 32 + tid, RLX_AGENT);
            sp[tid * 9] = 0;
#pragma unroll
            for (int sh = 0; sh < NSHARD; ++sh) { c += (int)cs[sh]; sp[tid * 9 + sh + 1] = c; } }
        const int n = (c + 255) >> 8;
        int inc = n;
#pragma unroll
        for (int o = 1; o < 32; o <<= 1) { const int t = __shfl_up(inc, o); if (tid >= o) inc += t; }
        const int start = inc - n;
        if (tid < 32) { lcnt[tid] = c;
#pragma unroll 1
            for (int mt = 0; mt < n; ++mt) { if (start + mt < 128) { tile_e[start + mt] = tid; tile_mt[start + mt] = mt; } } }
        if (tid == 31) lnt[0] = inc < 128 ? inc : 128;
    }
    __syncthreads();
    return lnt[0];
}

__global__ void __launch_bounds__(NWAVES * 64, 2) mk_fwd(Args args) {
    extern __shared__ __attribute__((aligned(16))) unsigned char lds_raw[];
    LAS unsigned char* lds = (LAS unsigned char*)lds_raw;
    volatile LAS unsigned* MISC = (volatile LAS unsigned*)(lds + MISC_OFF);
    const int G = gridDim.x; const int bx = blockIdx.x; const int vcu = (G % 8 == 0) ? (bx % 8) * (G / 8) + bx / 8 : bx;
    unsigned char* ws = args.ws;
    gu32* ctl = (gu32*)(ws + WS_CTL);
    for (int u = threadIdx.x; u < (LDS_BYTES - LDSCTL_OFF) / 4; u += NWAVES * 64) ((LAS unsigned*)(lds + LDSCTL_OFF))[u] = 0u;
    __syncthreads();
    XcdBarrier bar; bar.bar = (unsigned*)ctl + CW_BAR; bar.x = 0; bar.st = nullptr;
    if (MK_N_LAUNCHES == 1) bar = xcd_barrier_post((unsigned*)ctl + CW_BAR, MISC + 8);
#ifndef MK_BAR_REP
#define MK_BAR_REP 1
#endif
#define GRID_BAR() do { if (MK_N_LAUNCHES == 1) { _Pragma("unroll 1") for (int br_ = 0; br_ < MK_BAR_REP; ++br_) xcd_barrier(bar); } } while (0)
#ifndef MK_STRETCH_PH
#define MK_STRETCH_PH -1
#endif
#ifndef MK_STRETCH_MUL
#define MK_STRETCH_MUL 3
#endif
#ifndef MK_STRETCH_ROLE
#define MK_STRETCH_ROLE 0
#endif
#define STRETCH(pid) do { if (MK_STRETCH_PH >= 0 && (pid) == MK_STRETCH_PH && stretch_ok) { asm volatile("s_waitcnt vmcnt(0)" ::: "memory"); if (threadIdx.x == 0) { \
        const unsigned long long t1_ = __builtin_amdgcn_s_memrealtime(), t0_ = (unsigned long long)MISC[16] | ((unsigned long long)MISC[17] << 32), dt_ = (t1_ - t0_) * MK_STRETCH_MUL; \
        while (__builtin_amdgcn_s_memrealtime() - t1_ < dt_) __builtin_amdgcn_s_sleep(8); } } } while (0)
#define STAMP0() do { if (MK_STRETCH_PH >= 0 && threadIdx.x == 0) { const unsigned long long t_ = __builtin_amdgcn_s_memrealtime(); MISC[16] = (unsigned)t_; MISC[17] = (unsigned)(t_ >> 32); } } while (0)
#define GRID_BAR_P(pid) do { STRETCH(pid); GRID_BAR(); STAMP0(); } while (0)
    bool stretch_ok = true; (void)stretch_ok;
    STAMP0();
    const int lo = args.ph_lo, hi = args.ph_hi;
#ifndef PH_MASK
#define PH_MASK 0x1ff
#endif
#define PHON(j) (((PH_MASK) >> (j)) & 1)
#define IN(k) (lo <= (k) && (k) < hi)
#define BOTH(k) (IN(k) && IN((k) + 1))

#define PHASE_IDS() int tid_ = threadIdx.x; asm volatile("" : "+v"(tid_)); const int tid = tid_, lane = tid & 63, wave = __builtin_amdgcn_readfirstlane(tid >> 6); (void)tid; (void)lane; (void)wave
    if (PHON(0) && IN(0)) { PHASE_IDS(); REP(0, true) phase_prologue(args, lds, vcu, G, wave, lane); if (BOTH(0)) GRID_BAR_P(0); }

    constexpr int GU_SPLIT = 23552;
    constexpr int WIN_EARLY = 2560;
    constexpr int NG2 = 218;
    for (int l = 0; l < DEPTH; ++l) {
        const int pb = 1 + 8 * l;
        unsigned char* wl = ws + WS_WL + (size_t)l * WL_STRIDE;
        if (PHON(1) && IN(pb + 0)) {
            PHASE_IDS();
            if (bx >= NG2) { cvt_run(args, CVT_GU, l, (bx - NG2) * NWAVES + wave, (256 - NG2) * NWAVES, (LAS float*)(lds + wave * 16384), lane, 0, GU_SPLIT, MK_PACE2);
                if (l + 1 < DEPTH) cvt_run(args, CVT_WIN, l + 1, (bx - NG2) * NWAVES + wave, (256 - NG2) * NWAVES, (LAS float*)(lds + wave * 16384), lane, 0, WIN_EARLY); }
            if (bx < NG2) {
            SchedPlain S; S.T.init(M, INC, NG2, bx); S.A = (const char*)(ws + WS_H); S.Bt = (const char*)(wl + WL_IN); S.tstep = (size_t)256 * D * 2;
            EpiInProj E{(bf16*)(ws + WS_P), (const float*)(ws + WS_ROPE)};
            REP(1, true) pg8::gemm_phase<EpiInProj, SchedPlain, true, false>(lds, D, S, E);
            }
            if (MK_STRETCH_ROLE) stretch_ok = (MK_STRETCH_ROLE == 1) == (bx < NG2);
            if (BOTH(pb + 0)) GRID_BAR_P(pb + 0); else STRETCH(pb + 0);
            stretch_ok = true;
        }
        if (PHON(2) && IN(pb + 1)) { PHASE_IDS(); REP(2, true) phase_attn_conv(args, l, lds, G, vcu, tid, wave, lane, GU_SPLIT); if (BOTH(pb + 1)) GRID_BAR_P(pb + 1); else STRETCH(pb + 1); }
        if (PHON(3) && IN(pb + 2)) {
            SchedPair S; S.T.init(M, D, G, bx); S.A0 = (const char*)(ws + WS_AO); S.A1 = (const char*)(ws + WS_CV); S.B0 = (const char*)(wl + WL_A); S.B1 = (const char*)(wl + WL_C); S.tstep = (size_t)256 * 1024 * 2;
            EpiMerge E{(const bf16*)(ws + WS_P), (bf16*)(ws + WS_MG)};
            REP(3, true) pg8::gemm_phase<EpiMerge, SchedPair, true, false>(lds, 1024, S, E);
            if (BOTH(pb + 2)) GRID_BAR_P(pb + 2); else STRETCH(pb + 2);
        }
        if (PHON(4) && IN(pb + 3)) {
            SchedPlain S; S.T.init(M, D, G, bx); S.A = (const char*)(ws + WS_MG); S.Bt = (const char*)(wl + WL_O); S.tstep = (size_t)256 * D * 2;
            EpiResHx E{l == 0 ? args.in[0] : (const float*)(ws + WS_XRES), (float*)(ws + WS_XRES), (bf16*)(ws + WS_H), args.in[8] + (size_t)l * D, (float*)(ws + WS_PART)};
            REP(4, l == 0) pg8::gemm_phase<EpiResHx, SchedPlain, true, false>(lds, D, S, E);
            if (BOTH(pb + 3)) GRID_BAR_P(pb + 3); else STRETCH(pb + 3);
        }
        if (PHON(5) && IN(pb + 4)) { PHASE_IDS(); REP(5, true) phase_norm_router(args, l, lds, G, vcu, tid, wave, lane, rep_); if (BOTH(pb + 4)) GRID_BAR_P(pb + 4); else STRETCH(pb + 4); }
        if (PHON(6) && IN(pb + 5)) {
            PHASE_IDS();
            const int ntiles = moe_tables(args, l, lds, tid);
            int NG7; { const int th = (ntiles + 1) >> 1, rounds = (th + 27) / 28, per = (th + rounds - 1) / rounds; NG7 = 8 * per; }
            if (bx >= NG7) { const int cw = (bx - NG7) * NWAVES + wave, cn = (256 - NG7) * NWAVES; LAS float* scr = (LAS float*)(lds + wave * 16384);
                cvt_run(args, CVT_B, l, cw, cn, scr, lane, 0, 1 << 30, MK_PACE7);
                if (l + 1 < DEPTH) { cvt_run(args, CVT_WIN, l + 1, cw, cn, scr, lane, WIN_EARLY, 1 << 30, MK_PACE7 / 2); if ((ntiles * 8 + 223) / 224 != (ntiles * 8 + 255) / 256) cvt_run(args, CVT_S, l + 1, cw, cn, scr, lane); } }
            if (bx < NG7) {
            LAS int* tile_e = (LAS int*)(lds + TILE_OFF); LAS int* tile_mt = tile_e + 128; LAS int* lcnt = tile_e + 256;
            LAS unsigned* gtab = (LAS unsigned*)(lds + GTAB_OFF); LAS int* ltab = (LAS int*)(lds + LTAB_OFF);
            const int* tok = (const int*)(ws + WS_TOK);
            for (int idx = tid; idx < 4 * 256; idx += 512) {
                const int ui = idx >> 8, rr = idx & 255; unsigned off = 0u;
                const int th = (ntiles + 1) >> 1, t = ui * (NG7 >> 3) + (bx >> 3), tile = ((bx & 7) >> 2) * th + t;
                int li = -1;
                if (t < th && tile < ntiles) { const int e = tile_e[tile], pos = tile_mt[tile] * 256 + rr; if (pos < lcnt[e]) { li = slot_index(tile_e + 320, e, pos); off = (unsigned)(tok[li] >> 1) * (unsigned)(D * 2); } }
                gtab[idx] = off; ltab[idx] = li;
            }
            __syncthreads();
            SchedMoe S; S.tile_e = tile_e; S.tile_mt = tile_mt; S.gtab = gtab; S.ntiles = ntiles; S.nN = 4; S.G = NG7; S.c = bx;
            S.A = (const char*)(ws + WS_H); S.Bt = (const char*)(wl + WL_GU); S.a_tstep = 0; S.b_estep = (size_t)1024 * D * 2; S.b_tstep = (size_t)256 * D * 2; S.gather = true;
            EpiMoeGU E{(bf16*)(ws + WS_ACT), (const float*)(ws + WS_WGT), (const float*)(ws + WS_RSL), ltab};
            REP(6, true) pg8::gemm_phase<EpiMoeGU, SchedMoe, true, true>(lds, D, S, E);
            }
            if (MK_STRETCH_ROLE) stretch_ok = (MK_STRETCH_ROLE == 1) == (bx < NG7);
            if (BOTH(pb + 5)) GRID_BAR_P(pb + 5); else STRETCH(pb + 5);
            stretch_ok = true;
        }
        if (PHON(7) && IN(pb + 6)) {
            PHASE_IDS();
            const int ntiles = (MK_N_LAUNCHES == 1) ? ((LAS int*)(lds + TILE_OFF))[288] : moe_tables(args, l, lds, tid);
            const int NG8 = (l + 1 < DEPTH && (ntiles * 8 + 223) / 224 == (ntiles * 8 + 255) / 256) ? 224 : 256;
            if (bx >= NG8 && l + 1 < DEPTH) cvt_run(args, CVT_S, l + 1, (bx - NG8) * NWAVES + wave, (256 - NG8) * NWAVES, (LAS float*)(lds + wave * 16384), lane);
            if (bx < NG8) {
            LAS int* tile_e = (LAS int*)(lds + TILE_OFF); LAS int* tile_mt = tile_e + 128; LAS int* lcnt = tile_e + 256;
            LAS int* ltab = (LAS int*)(lds + LTAB_OFF);
            for (int idx = tid; idx < 4 * 256; idx += 512) {
                const int ui = idx >> 8, rr = idx & 255, L = ui * NG8 + bx; int li = -1;
                if (L < ntiles * 8) { const int tile = L >> 3, e = tile_e[tile], pos = tile_mt[tile] * 256 + rr; if (pos < lcnt[e]) li = slot_index(tile_e + 320, e, pos); }
                ltab[idx] = li;
            }
            __syncthreads();
            SchedMoe S; S.tile_e = tile_e; S.tile_mt = tile_mt; S.gtab = (LAS unsigned*)(lds + GTAB_OFF); S.ntiles = ntiles; S.nN = 8; S.G = NG8; S.c = bx;
            S.A = (const char*)(ws + WS_ACT); S.Bt = (const char*)(wl + WL_D); S.a_tstep = (size_t)256 * FF * 2; S.b_estep = (size_t)D * FF * 2; S.b_tstep = (size_t)256 * FF * 2; S.gather = false;
            EpiMoeDown E{(bf16*)(ws + WS_Y2), (const int*)(ws + WS_TOK), ltab};
            REP(7, true) pg8::gemm_phase<EpiMoeDown, SchedMoe, true, false>(lds, FF, S, E);
            }
            if (BOTH(pb + 6)) GRID_BAR_P(pb + 6); else STRETCH(pb + 6);
        }
        if (PHON(8) && IN(pb + 7)) {
            PHASE_IDS();
            const int gw = vcu * NWAVES + wave, NGW = G * NWAVES;
            float* X = (float*)(ws + WS_XRES); const bf16* Y2 = (const bf16*)(ws + WS_Y2);
            REP(8, l + 1 == DEPTH) for (int m = gw; m < M; m += NGW) {
                if (l + 1 < DEPTH) norm_row(X + (size_t)m * D, Y2 + (size_t)(2 * m) * D, Y2 + (size_t)(2 * m + 1) * D, X + (size_t)m * D, args.in[1] + (size_t)(l + 1) * D, (bf16*)(ws + WS_H) + (size_t)m * D, nullptr, lane);
                else norm_row(X + (size_t)m * D, Y2 + (size_t)(2 * m) * D, Y2 + (size_t)(2 * m + 1) * D, nullptr, args.in[16], nullptr, args.out + (size_t)m * D, lane);
            }
            if (BOTH(pb + 7)) GRID_BAR_P(pb + 7); else STRETCH(pb + 7);
        }
    }
#undef IN
#undef BOTH
}

extern "C" void kernel_launch(void* const* d_in, const int* in_sizes, int n_in, void* d_out, int out_size, void* d_ws, size_t ws_size, hipStream_t stream) {
    static int grid = 0;
    if (grid == 0) {
        if (n_in != 17 || in_sizes[0] != M * D || out_size != M * D || ws_size < WS_END) { fprintf(stderr, "kernel_launch: unexpected shapes (n_in %d, in0 %d, out %d, ws %zu)\n", n_in, n_in > 0 ? in_sizes[0] : -1, out_size, ws_size); grid = -1; return; }
        int dev = 0, cus = 0, per_cu = 0;
        if (hipGetDevice(&dev) != hipSuccess || hipDeviceGetAttribute(&cus, hipDeviceAttributeMultiprocessorCount, dev) != hipSuccess) { grid = -1; return; }
        if (hipFuncSetAttribute((const void*)mk_fwd, hipFuncAttributeMaxDynamicSharedMemorySize, LDS_BYTES) != hipSuccess) { fprintf(stderr, "kernel_launch: hipFuncSetAttribute failed\n"); grid = -1; return; }
        if (hipOccupancyMaxActiveBlocksPerMultiprocessor(&per_cu, (const void*)mk_fwd, NWAVES * 64, LDS_BYTES) != hipSuccess || per_cu < 1)
            fprintf(stderr, "kernel_launch: occupancy query reports %d workgroups per CU\n", per_cu);
        (void)hipGetLastError();
        if (cus != 256) { fprintf(stderr, "kernel_launch: built for a 256-CU device (got %d CUs); nothing launched\n", cus); grid = -1; return; }
        grid = cus;
    }
    if (grid < 0) return;
    if (hipMemsetAsync((char*)d_ws + WS_CTL, 0, CTL_ZERO_BYTES, stream) != hipSuccess) return;
    Args a{};
    for (int i = 0; i < 17; ++i) a.in[i] = (const float*)d_in[i];
    a.out = (float*)d_out; a.ws = (unsigned char*)d_ws;
    if (MK_N_LAUNCHES == 1) {
        a.ph_lo = 0; a.ph_hi = NPHASE; a.li = 0;
        hipLaunchKernelGGL(mk_fwd, dim3(grid), dim3(NWAVES * 64), LDS_BYTES, stream, a);
    } else {
        for (int p = 0; p < MK_PH_END; ++p) { a.ph_lo = p; a.ph_hi = p + 1; a.li = p; hipLaunchKernelGGL(mk_fwd, dim3(grid), dim3(NWAVES * 64), LDS_BYTES, stream, a); }
    }
    const hipError_t le = hipPeekAtLastError();
    if (le != hipSuccess) fprintf(stderr, "kernel_launch: launch failed: %s\n", hipGetErrorName(le));
}
```

```cpp
#include <hip/hip_runtime.h>
#include <cstdio>
#include <cstdint>

#ifndef MK_REPEAT
#define MK_REPEAT 0
#endif
#define REP(k, cond) _Pragma("unroll 1") for (int rep_ = 0; rep_ < 1 + ((((MK_REPEAT) >> (k)) & 1) && (cond) ? 1 : 0); ++rep_)
#ifndef MK_PH_END
#define MK_PH_END 17
#endif
#ifndef MK_PACE7
#define MK_PACE7 2
#endif
#ifndef MK_PACE2
#define MK_PACE2 0
#endif
#ifndef MK_N_LAUNCHES
#define MK_N_LAUNCHES 1
#endif

constexpr int D = 2048, SEQ = 4096, M = 8192, DEPTH = 2;
constexpr int INC = 8704;
constexpr int C_Q = 0, C_K = 1024, C_V = 1280, C_CB = 1536, C_CC = 2560, C_CX = 3584, C_GA = 4608, C_GC = 6656;
constexpr int NE = 32, FF = 512;
constexpr float NORM_EPS = 1e-5f;
constexpr int NPHASE = 1 + 8 * DEPTH;

constexpr size_t MiB = 1u << 20;
constexpr size_t WS_CTL = 0, CTL_ZERO_BYTES = 128 * 1024;
constexpr size_t WS_ROPE = 1 * MiB;
constexpr size_t WS_TOK = 2 * MiB;
constexpr size_t WS_WGT = 3 * MiB;
constexpr size_t WS_WL = 4 * MiB, WL_STRIDE = 243 * MiB;
constexpr size_t WL_IN = 0, WL_A = 34 * MiB, WL_C = 38 * MiB, WL_O = 42 * MiB, WL_GU = 50 * MiB, WL_D = 178 * MiB, WL_R = 242 * MiB;
constexpr size_t WR_LO_OFF = 48 * 2048 * 2;
constexpr size_t WS_XRES = 490 * MiB;
constexpr size_t WS_H = 554 * MiB;
constexpr size_t WS_P = 586 * MiB;
constexpr size_t WS_Y2 = WS_P;
constexpr size_t WS_AO = 722 * MiB, WS_CV = 738 * MiB;
constexpr size_t WS_PART = 754 * MiB;
constexpr size_t WS_RSL = 756 * MiB;
constexpr size_t WS_MG = 818 * MiB;
constexpr size_t WS_ACT = 850 * MiB;
constexpr size_t WS_END = 874 * MiB;
constexpr int CW_TMO = 0, CW_CODE = 1, CW_BAR = 4096, CW_CNT = 16384;

constexpr int RING_BYTES = 131072;
constexpr int LDSCTL_OFF = RING_BYTES;
constexpr int MISC_OFF = LDSCTL_OFF + 320;
constexpr int TILE_OFF = LDSCTL_OFF + 1024;
constexpr int GTAB_OFF = LDSCTL_OFF + 4096;
constexpr int LTAB_OFF = LDSCTL_OFF + 8192;
constexpr int RB = 4;
constexpr int GU_SPLIT2 = 32768 - 3584;
constexpr int NSHARD = 8, SHARD_CAP = 1024;
constexpr int LDS_BYTES = 147456;
constexpr int NWAVES = 8;

#define GAS __attribute__((address_space(1)))
#define LAS __attribute__((address_space(3)))
typedef unsigned short bf16;
typedef unsigned v4u __attribute__((ext_vector_type(4)));
typedef unsigned v2u __attribute__((ext_vector_type(2)));
typedef float f32x4 __attribute__((ext_vector_type(4)));
typedef float f32x16 __attribute__((ext_vector_type(16)));
typedef short bf16x8 __attribute__((ext_vector_type(8)));
typedef short s16x4 __attribute__((ext_vector_type(4)));
typedef GAS unsigned gu32;
#define RLX_AGENT __ATOMIC_RELAXED, __HIP_MEMORY_SCOPE_AGENT
#define LDS_WAIT() asm volatile("s_waitcnt lgkmcnt(0)" ::: "memory")
#define VM_WAIT() asm volatile("s_waitcnt vmcnt(0)" ::: "memory")

__device__ __forceinline__ unsigned f2bf(float f) { unsigned u = __builtin_bit_cast(unsigned, f); return (u + 0x7fffu + ((u >> 16) & 1u)) >> 16; }
__device__ __forceinline__ unsigned pk2i(float lo, float hi) { return f2bf(lo) | (f2bf(hi) << 16); }
typedef float f32x2_t __attribute__((ext_vector_type(2))); typedef __bf16 bf16x2_t __attribute__((ext_vector_type(2)));
__device__ __forceinline__ unsigned pk2(float lo, float hi) { const f32x2_t v = {lo, hi}; const bf16x2_t b = __builtin_convertvector(v, bf16x2_t); return __builtin_bit_cast(unsigned, b); }
__device__ __forceinline__ float bflo(unsigned w) { return __builtin_bit_cast(float, w << 16); }
__device__ __forceinline__ float bfhi(unsigned w) { return __builtin_bit_cast(float, w & 0xffff0000u); }
__device__ __forceinline__ float sigmoidf_(float v) { return __builtin_amdgcn_rcpf(1.0f + __expf(-v)); }

namespace pg8 {
#define PG8_LAS __attribute__((address_space(3)))
typedef unsigned short bf16_t;
constexpr int BM = 256, BK = 64, HALF = 128, HTB = HALF * BK * 2, STAGE_BYTES = 8 * HTB, NXCD = 8, WGM = 8;

__host__ __device__ __forceinline__ int lds_byte(int r, int c) { const int st = (r >> 4) * 2 + (c >> 5), rr = r & 15, cc = c & 31, ob = rr * 64 + cc * 2; return st * 1024 + (ob ^ (((ob >> 9) & 1) << 5)); }
__host__ __device__ __forceinline__ void stage_rc(int b, int& R, int& C) { const int st = b / 1024, sb = b % 1024, swz = sb ^ (((sb >> 9) & 1) << 5); R = (st >> 1) * 16 + swz / 64; C = (st & 1) * 32 + (swz % 64) / 2; }
__host__ __device__ __forceinline__ int perm32(int rho) { const int n = rho >> 4, i = rho & 15; return 8 * (i >> 2) + 4 * n + (i & 3); }

struct Unit { int pm, pn, aux; };

struct TileOrder {
    int nM, nN, nwg, G, c;
    __device__ void init(int Mr, int Nc, int G_, int c_) { nM = Mr / BM; nN = Nc / BM; nwg = nM * nN; G = G_; c = c_; }
    __device__ bool tile(int i, int& pm, int& pn) const {
        const long L = (long)i * G + c; if (L >= nwg) return false;
        int wgid = (int)L; { const int q = nwg / NXCD, r = nwg % NXCD, xcd = wgid % NXCD, off = wgid / NXCD; wgid = (xcd < r ? xcd * (q + 1) : r * (q + 1) + (xcd - r) * q) + off; }
        const int nig = WGM * nN, gid = wgid / nig, fm = gid * WGM, gsz = (nM - fm) < WGM ? (nM - fm) : WGM;
        pm = fm + ((wgid % nig) % gsz); pn = (wgid % nig) / gsz; return true;
    }
};

template <class Epi, class Sched, bool ALIGN_EPI, bool GATHER>
__device__ __forceinline__ void gemm_phase(PG8_LAS unsigned char* lds, const int K, const Sched& S, const Epi& E) {
    int tid_ = threadIdx.x; asm volatile("" : "+v"(tid_));
    const int tid = tid_, wid = __builtin_amdgcn_readfirstlane(tid >> 6), lane = tid & 63, wr = wid >> 2, wc = wid & 3, fr = lane & 15, fq = lane >> 4;
    const int nt = K / BK;
    unsigned voffA[2], voffB[2]; int RA[2]; unsigned CA[2];
#pragma unroll
    for (int i = 0; i < 2; ++i) { int R, C; stage_rc(tid * 16 + i * 8192, R, C); const int Rb = Epi::PERM ? ((R & ~31) + perm32(R & 31)) : R;
        voffA[i] = (unsigned)(R * K + C) * 2u; voffB[i] = (unsigned)(Rb * K + C) * 2u; RA[i] = R; CA[i] = (unsigned)C * 2u; }
    const size_t kstep = (size_t)(BK * 2);
    const size_t hstep = (size_t)HALF * K * 2;
    const unsigned ldsw = (unsigned)wid * 1024u;
    const int aoff = lds_byte(wr * 64 + fr, fq * 8), boff = lds_byte(wc * 32 + fr, fq * 8);
    unsigned gvo[2][2], ngvo[2][2];
#define PG8_SA(b, h) (((b) * 2 + (h)) * HTB)
#define PG8_SB(b, h) ((4 + (b) * 2 + (h)) * HTB)
#define PG8_STAGE2(bufoff, gbase, v0, v1) do { \
        __builtin_amdgcn_global_load_lds((const unsigned*)((const char*)(gbase) + (v0)), (PG8_LAS unsigned*)(lds + (bufoff) + ldsw), 16, 0, 0); \
        __builtin_amdgcn_global_load_lds((const unsigned*)((const char*)(gbase) + (v1)), (PG8_LAS unsigned*)(lds + (bufoff) + ldsw + 8192), 16, 0, 0); } while (0)
#define PG8_STAGE_B(bufoff, gbase) PG8_STAGE2(bufoff, gbase, voffB[0], voffB[1])
#define PG8_STAGE_A(bufoff, kbase, h, nx) do { if constexpr (GATHER) { const unsigned _v0 = (nx) ? ngvo[h][0] : gvo[h][0], _v1 = (nx) ? ngvo[h][1] : gvo[h][1]; PG8_STAGE2(bufoff, kbase, _v0, _v1); } \
        else { PG8_STAGE2(bufoff, (kbase) + (h) * hstep, voffA[0], voffA[1]); } } while (0)
#define PG8_LDA(dst, b, h) do { _Pragma("unroll") for (int m = 0; m < 4; ++m) _Pragma("unroll") for (int k = 0; k < 2; ++k) dst[m][k] = *(const PG8_LAS bf16x8*)(lds + PG8_SA(b, h) + aoff + m * 2048 + k * 1024); } while (0)
#define PG8_LDB(dst, b, h) do { _Pragma("unroll") for (int n = 0; n < 2; ++n) _Pragma("unroll") for (int k = 0; k < 2; ++k) dst[n][k] = *(const PG8_LAS bf16x8*)(lds + PG8_SB(b, h) + boff + n * 2048 + k * 1024); } while (0)
#define PG8_MMA(ai, bj, At, Bt) do { __builtin_amdgcn_s_setprio(1); _Pragma("unroll") for (int m = 0; m < 4; ++m) _Pragma("unroll") for (int n = 0; n < 2; ++n) _Pragma("unroll") for (int k = 0; k < 2; ++k) \
        acc[ai][bj][m][n] = __builtin_amdgcn_mfma_f32_16x16x32_bf16(Bt[n][k], At[m][k], acc[ai][bj][m][n], 0, 0, 0); __builtin_amdgcn_s_setprio(0); } while (0)
#define PG8_WAIT_V(n) asm volatile("s_waitcnt vmcnt(" #n ")" ::: "memory")
#define PG8_WAIT_L(n) asm volatile("s_waitcnt lgkmcnt(" #n ")" ::: "memory")
#define PG8_BAR __builtin_amdgcn_s_barrier()
#define PG8_SCHED __builtin_amdgcn_sched_barrier(0)
    Unit cur, nxt; int ui = 0;
    if (!S.next(0, cur)) return;
    f32x4 acc[2][2][4][2];
    E.init(acc, cur, wr, wc, fr, fq);
    bf16x8 At[4][2], B0[2][2], B1[2][2];
    const char* cA = S.abase(cur); const char* cB = S.bbase(cur);
    if constexpr (GATHER) {
#pragma unroll
        for (int h = 0; h < 2; ++h)
#pragma unroll
            for (int i = 0; i < 2; ++i) { gvo[h][i] = S.goff(0, h * HALF + RA[i]) + CA[i]; ngvo[h][i] = gvo[h][i]; }
    }
    PG8_STAGE_B(PG8_SB(0, 0), cB); PG8_STAGE_B(PG8_SB(0, 1), cB + hstep); PG8_STAGE_A(PG8_SA(0, 0), cA, 0, false); PG8_STAGE_A(PG8_SA(0, 1), cA, 1, false);
    if (wr == 1) PG8_BAR;
    PG8_WAIT_V(2); PG8_BAR;
    PG8_STAGE_B(PG8_SB(1, 0), cB + kstep); PG8_STAGE_A(PG8_SA(1, 0), cA + kstep, 0, false); PG8_STAGE_B(PG8_SB(1, 1), cB + hstep + kstep);
    PG8_WAIT_V(6); PG8_BAR;
    for (;;) {
        const bool has_next = S.next(ui + 1, nxt);
        const char* nA = has_next ? S.abase(nxt) : cA; const char* nB = has_next ? S.bbase(nxt) : cB;
        if constexpr (GATHER) {
            if (has_next) {
#pragma unroll
                for (int h = 0; h < 2; ++h)
#pragma unroll
                    for (int i = 0; i < 2; ++i) ngvo[h][i] = S.goff(ui + 1, h * HALF + RA[i]) + CA[i];
            }
        }
        for (int t = 0; t < nt; t += 2) {
            const bool last = (t == nt - 2);
            const char* a1 = cA + (size_t)(t + 1) * kstep;
            const char* a2 = last ? nA : cA + (size_t)(t + 2) * kstep; const char* b2 = last ? nB : cB + (size_t)(t + 2) * kstep;
            const char* a3 = a2 + kstep; const char* b3 = b2 + kstep;
            PG8_LDB(B0, 0, 0); PG8_LDB(B1, 0, 1); PG8_SCHED; PG8_LDA(At, 0, 0); PG8_STAGE_A(PG8_SA(1, 1), a1, 1, false);
            PG8_WAIT_V(8); PG8_WAIT_L(0); PG8_BAR; PG8_MMA(0, 0, At, B0); PG8_MMA(0, 1, At, B1); PG8_BAR; PG8_SCHED;
            PG8_LDA(At, 0, 1); PG8_STAGE_B(PG8_SB(0, 0), b2); PG8_STAGE_B(PG8_SB(0, 1), b2 + hstep); PG8_STAGE_A(PG8_SA(0, 0), a2, 0, last);
            PG8_WAIT_V(8); PG8_WAIT_L(0); PG8_BAR; PG8_MMA(1, 0, At, B0); PG8_MMA(1, 1, At, B1); PG8_BAR; PG8_SCHED;
            PG8_LDB(B0, 1, 0); PG8_LDB(B1, 1, 1); PG8_SCHED; PG8_LDA(At, 1, 0); PG8_STAGE_A(PG8_SA(0, 1), a2, 1, last);
            PG8_WAIT_V(8); PG8_WAIT_L(0); PG8_BAR; PG8_MMA(0, 0, At, B0); PG8_MMA(0, 1, At, B1); PG8_BAR; PG8_SCHED;
            PG8_LDA(At, 1, 1); PG8_STAGE_B(PG8_SB(1, 0), b3); PG8_STAGE_B(PG8_SB(1, 1), b3 + hstep); PG8_STAGE_A(PG8_SA(1, 0), a3, 0, last);
            PG8_WAIT_V(8); PG8_WAIT_L(0); PG8_BAR; PG8_MMA(1, 0, At, B0); PG8_MMA(1, 1, At, B1); PG8_BAR; PG8_SCHED;
        }
        if constexpr (ALIGN_EPI) { if (wr == 0) PG8_BAR; }
        E(acc, cur, wr, wc, fr, fq);
        if (!has_next) break;
        if (!E.keep_acc(cur)) E.init(acc, nxt, wr, wc, fr, fq);
        cur = nxt; cA = nA; cB = nB; ++ui;
        if constexpr (GATHER) {
#pragma unroll
            for (int h = 0; h < 2; ++h)
#pragma unroll
                for (int i = 0; i < 2; ++i) gvo[h][i] = ngvo[h][i];
        }
        if constexpr (ALIGN_EPI) { if (wr == 1) PG8_BAR; }
    }
    PG8_WAIT_V(0);
    if constexpr (!ALIGN_EPI) { if (wr == 0) PG8_BAR; }
    PG8_BAR;
#undef PG8_SA
#undef PG8_SB
#undef PG8_STAGE2
#undef PG8_STAGE_A
#undef PG8_STAGE_B
#undef PG8_LDA
#undef PG8_LDB
#undef PG8_MMA
#undef PG8_WAIT_V
#undef PG8_WAIT_L
#undef PG8_BAR
#undef PG8_SCHED
}
}

struct SchedPlain {
    pg8::TileOrder T; const char* A; const char* Bt; size_t tstep;
    __device__ __forceinline__ bool next(int i, pg8::Unit& u) const { u.aux = 0; return T.tile(i, u.pm, u.pn); }
    __device__ __forceinline__ const char* abase(const pg8::Unit& u) const { return A + (size_t)u.pm * tstep; }
    __device__ __forceinline__ const char* bbase(const pg8::Unit& u) const { return Bt + (size_t)u.pn * tstep; }
    __device__ __forceinline__ unsigned goff(int, int) const { return 0u; }
};
struct SchedPair {
    pg8::TileOrder T; const char* A0; const char* A1; const char* B0; const char* B1; size_t tstep;
    __device__ __forceinline__ bool next(int i, pg8::Unit& u) const { u.aux = i & 1; return T.tile(i >> 1, u.pm, u.pn); }
    __device__ __forceinline__ const char* abase(const pg8::Unit& u) const { return (u.aux ? A1 : A0) + (size_t)u.pm * tstep; }
    __device__ __forceinline__ const char* bbase(const pg8::Unit& u) const { return (u.aux ? B1 : B0) + (size_t)u.pn * tstep; }
    __device__ __forceinline__ unsigned goff(int, int) const { return 0u; }
};
struct SchedMoe {
    const LAS int* tile_e; const LAS int* tile_mt; const LAS unsigned* gtab; int ntiles, nN, G, c;
    const char* A; const char* Bt; size_t a_tstep, b_estep, b_tstep; bool gather;
    __device__ __forceinline__ bool next(int i, pg8::Unit& u) const {
        int tile, pn;
        if (nN == 4) { const int x = c & 7, j = c >> 3, th = (ntiles + 1) >> 1, t = i * (G >> 3) + j; if (t >= th) return false; tile = (x >> 2) * th + t; if (tile >= ntiles) return false; pn = x & 3; }
        else { const int L = i * G + c; if (L >= ntiles * nN) return false; tile = L / nN; pn = L - tile * nN; }
        u.pm = tile; u.pn = pn; u.aux = tile_e[tile] | (tile_mt[tile] << 8) | (i << 16); return true; }
    __device__ __forceinline__ const char* abase(const pg8::Unit& u) const { return gather ? A : A + (size_t)u.pm * a_tstep; }
    __device__ __forceinline__ const char* bbase(const pg8::Unit& u) const { return Bt + (size_t)(u.aux & 255) * b_estep + (size_t)u.pn * b_tstep; }
    __device__ __forceinline__ unsigned goff(int ui, int row) const { return gtab[ui * 256 + row]; }
};

using pg8::Unit;
struct EpiInProj {
    static constexpr bool PERM = true;
    bf16* P; const float* rope;
    __device__ __forceinline__ bool keep_acc(const Unit&) const { return false; }
    __device__ __forceinline__ void init(f32x4 (&acc)[2][2][4][2], const Unit&, int, int, int, int) const {
#pragma unroll
        for (int a = 0; a < 2; ++a)
#pragma unroll
            for (int b = 0; b < 2; ++b)
#pragma unroll
                for (int m = 0; m < 4; ++m)
#pragma unroll
                    for (int n = 0; n < 2; ++n) acc[a][b][m][n] = (f32x4){0.f, 0.f, 0.f, 0.f};
    }
    __device__ __forceinline__ void operator()(f32x4 (&acc)[2][2][4][2], const Unit& u, int wr, int wc, int fr, int fq) const {
        const int row0 = u.pm * 256 + wr * 64 + fr, col0 = u.pn * 256 + wc * 32 + 8 * fq;
        const int kind = u.pn <= 3 ? 0 : (u.pn == 4 ? 1 : (u.pn < 18 ? 2 : 3));
        const bool do_rope = (kind <= 1) && ((wc & 1) == 0);
        const float sgn = fq == 0 ? -1.f : 1.f;
#pragma unroll
        for (int ai = 0; ai < 2; ++ai)
#pragma unroll
            for (int m = 0; m < 4; ++m) {
                const int row = row0 + ai * 128 + m * 16;
                bf16* rowp = P + (size_t)row * INC + col0;
                f32x4 c0 = {1.f, 1.f, 1.f, 1.f}, c1 = c0, s0 = {0.f, 0.f, 0.f, 0.f}, s1 = s0;
                if (do_rope) { const f32x4* rp = (const f32x4*)(rope + (size_t)(row & (SEQ - 1)) * 16); c0 = rp[0]; c1 = rp[1]; s0 = rp[2]; s1 = rp[3]; }
#pragma unroll
                for (int bj = 0; bj < 2; ++bj) {
                    f32x4 v0 = acc[ai][bj][m][0], v1 = acc[ai][bj][m][1];
                    if (do_rope) {
                        f32x4 p0, p1;
#pragma unroll
                        for (int e = 0; e < 4; ++e) { p0[e] = __shfl_xor(v0[e], 16); p1[e] = __shfl_xor(v1[e], 16); }
                        if (fq < 2) { v0 = v0 * c0 + p0 * s0 * sgn; v1 = v1 * c1 + p1 * s1 * sgn; }
                    }
                    if (kind == 0) { v0 = v0 * 0.125f; v1 = v1 * 0.125f; }
                    if (kind == 3) {
#pragma unroll
                        for (int e = 0; e < 4; ++e) { v0[e] = sigmoidf_(v0[e]); v1[e] = sigmoidf_(v1[e]); }
                    }
                    v4u w; w.x = pk2(v0[0], v0[1]); w.y = pk2(v0[2], v0[3]); w.z = pk2(v1[0], v1[1]); w.w = pk2(v1[2], v1[3]);
                    *(v4u*)(rowp + bj * 128) = w;
                }
            }
    }
};
struct EpiMerge {
    static constexpr bool PERM = true;
    const bf16* P; bf16* MG;
    __device__ __forceinline__ bool keep_acc(const Unit& u) const { return u.aux == 0; }
    __device__ __forceinline__ void init(f32x4 (&acc)[2][2][4][2], const Unit&, int, int, int, int) const {
#pragma unroll
        for (int a = 0; a < 2; ++a)
#pragma unroll
            for (int b = 0; b < 2; ++b)
#pragma unroll
                for (int m = 0; m < 4; ++m)
#pragma unroll
                    for (int n = 0; n < 2; ++n) acc[a][b][m][n] = (f32x4){0.f, 0.f, 0.f, 0.f};
    }
    __device__ __forceinline__ void operator()(f32x4 (&acc)[2][2][4][2], const Unit& u, int wr, int wc, int fr, int fq) const {
        const int row0 = u.pm * 256 + wr * 64 + fr, col0 = u.pn * 256 + wc * 32 + 8 * fq;
#pragma unroll
        for (int ai = 0; ai < 2; ++ai)
#pragma unroll
            for (int m = 0; m < 4; ++m) {
                const int row = row0 + ai * 128 + m * 16;
                const bf16* gp = P + (size_t)row * INC + col0;
                v4u gc[2], ga[2];
#pragma unroll
                for (int bj = 0; bj < 2; ++bj) { gc[bj] = *(const v4u*)(gp + C_GC + bj * 128); if (u.aux == 0) ga[bj] = *(const v4u*)(gp + C_GA + bj * 128); }
#pragma unroll
                for (int bj = 0; bj < 2; ++bj) {
                    float f2[8] = {bflo(gc[bj].x), bfhi(gc[bj].x), bflo(gc[bj].y), bfhi(gc[bj].y), bflo(gc[bj].z), bfhi(gc[bj].z), bflo(gc[bj].w), bfhi(gc[bj].w)};
#pragma unroll
                    for (int e = 0; e < 8; ++e) f2[e] = __builtin_fmaxf(f2[e], 1e-30f);
                    f32x4& v0 = acc[ai][bj][m][0]; f32x4& v1 = acc[ai][bj][m][1];
                    if (u.aux == 0) {
                        const float sa[8] = {bflo(ga[bj].x), bfhi(ga[bj].x), bflo(ga[bj].y), bfhi(ga[bj].y), bflo(ga[bj].z), bfhi(ga[bj].z), bflo(ga[bj].w), bfhi(ga[bj].w)};
#pragma unroll
                        for (int e = 0; e < 4; ++e) { v0[e] *= sa[e] * __builtin_amdgcn_rcpf(f2[e]); v1[e] *= sa[4 + e] * __builtin_amdgcn_rcpf(f2[4 + e]); }
                    } else {
#pragma unroll
                        for (int e = 0; e < 4; ++e) { v0[e] *= f2[e]; v1[e] *= f2[4 + e]; }
                        v4u w; w.x = pk2(v0[0], v0[1]); w.y = pk2(v0[2], v0[3]); w.z = pk2(v1[0], v1[1]); w.w = pk2(v1[2], v1[3]);
                        *(v4u*)(MG + (size_t)row * D + col0 + bj * 128) = w;
                    }
                }
            }
    }
};
struct EpiResHx {
    static constexpr bool PERM = true;
    const float* base; float* out; bf16* HX; const float* g; float* part;
    __device__ __forceinline__ bool keep_acc(const Unit&) const { return false; }
    __device__ __forceinline__ void init(f32x4 (&acc)[2][2][4][2], const Unit& u, int wr, int wc, int fr, int fq) const {
        const int row0 = u.pm * 256 + wr * 64 + fr, col0 = u.pn * 256 + wc * 32 + 8 * fq;
#pragma unroll
        for (int ai = 0; ai < 2; ++ai)
#pragma unroll
            for (int m = 0; m < 4; ++m) { const size_t off = (size_t)(row0 + ai * 128 + m * 16) * D + col0;
#pragma unroll
                for (int bj = 0; bj < 2; ++bj) { acc[ai][bj][m][0] = *(const f32x4*)(base + off + bj * 128); acc[ai][bj][m][1] = *(const f32x4*)(base + off + bj * 128 + 4); } }
    }
    __device__ __forceinline__ void operator()(f32x4 (&acc)[2][2][4][2], const Unit& u, int wr, int wc, int fr, int fq) const {
        const int row0 = u.pm * 256 + wr * 64 + fr, col0 = u.pn * 256 + wc * 32 + 8 * fq;
        f32x4 gv[2][2];
#pragma unroll
        for (int bj = 0; bj < 2; ++bj) { gv[bj][0] = *(const f32x4*)(g + col0 + bj * 128); gv[bj][1] = *(const f32x4*)(g + col0 + bj * 128 + 4); }
#pragma unroll
        for (int ai = 0; ai < 2; ++ai)
#pragma unroll
            for (int m = 0; m < 4; ++m) {
                const int row = row0 + ai * 128 + m * 16; const size_t off = (size_t)row * D + col0;
                float ssum = 0.f;
#pragma unroll
                for (int bj = 0; bj < 2; ++bj) {
                    const f32x4 v0 = acc[ai][bj][m][0], v1 = acc[ai][bj][m][1];
                    *(f32x4*)(out + off + bj * 128) = v0; *(f32x4*)(out + off + bj * 128 + 4) = v1;
                    ssum += (v0.x * v0.x + v0.y * v0.y) + (v0.z * v0.z + v0.w * v0.w) + (v1.x * v1.x + v1.y * v1.y) + (v1.z * v1.z + v1.w * v1.w);
                    const f32x4 h0 = v0 * gv[bj][0], h1 = v1 * gv[bj][1];
                    v4u w; w.x = pk2(h0.x, h0.y); w.y = pk2(h0.z, h0.w); w.z = pk2(h1.x, h1.y); w.w = pk2(h1.z, h1.w);
                    *(v4u*)(HX + off + bj * 128) = w;
                }
                ssum += __shfl_xor(ssum, 16); ssum += __shfl_xor(ssum, 32);
                if (fq == 0) part[(size_t)row * 32 + u.pn * 4 + wc] = ssum;
            }
    }
};
struct EpiMoeGU {
    static constexpr bool PERM = true;
    bf16* ACT; const float* wgt; const float* rsl; const LAS int* ltab;
    __device__ __forceinline__ bool keep_acc(const Unit&) const { return false; }
    __device__ __forceinline__ void init(f32x4 (&acc)[2][2][4][2], const Unit&, int, int, int, int) const {
#pragma unroll
        for (int a = 0; a < 2; ++a)
#pragma unroll
            for (int b = 0; b < 2; ++b)
#pragma unroll
                for (int m = 0; m < 4; ++m)
#pragma unroll
                    for (int n = 0; n < 2; ++n) acc[a][b][m][n] = (f32x4){0.f, 0.f, 0.f, 0.f};
    }
    __device__ __forceinline__ void operator()(f32x4 (&acc)[2][2][4][2], const Unit& u, int wr, int wc, int fr, int fq) const {
        const LAS int* lt = ltab + (u.aux >> 16) * 256;
        const int f0 = u.pn * 128 + wc * 32 + 8 * fq;
        float wrow[2][4], rrow[2][4];
#pragma unroll
        for (int ai = 0; ai < 2; ++ai)
#pragma unroll
            for (int m = 0; m < 4; ++m) { const int li = lt[ai * 128 + wr * 64 + m * 16 + fr]; const bool ok = li >= 0; wrow[ai][m] = ok ? wgt[li] : 0.f; rrow[ai][m] = ok ? rsl[li] : 0.f; }
#pragma unroll
        for (int ai = 0; ai < 2; ++ai)
#pragma unroll
            for (int m = 0; m < 4; ++m) {
                const int rl = ai * 128 + wr * 64 + m * 16 + fr;
                const float w = wrow[ai][m] * rrow[ai][m], rsd = rrow[ai][m];
                const f32x4 g0 = acc[ai][0][m][0] * rsd, g1 = acc[ai][0][m][1] * rsd, u0 = acc[ai][1][m][0], u1 = acc[ai][1][m][1];
                f32x4 a0, a1;
#pragma unroll
                for (int k = 0; k < 4; ++k) { a0[k] = g0[k] * sigmoidf_(g0[k]) * u0[k] * w; a1[k] = g1[k] * sigmoidf_(g1[k]) * u1[k] * w; }
                v4u o; o.x = pk2(a0[0], a0[1]); o.y = pk2(a0[2], a0[3]); o.z = pk2(a1[0], a1[1]); o.w = pk2(a1[2], a1[3]);
                *(v4u*)(ACT + (size_t)(u.pm * 256 + rl) * FF + f0) = o;
            }
    }
};
struct EpiMoeDown {
    static constexpr bool PERM = true;
    bf16* Y2; const int* tok; const LAS int* ltab;
    __device__ __forceinline__ bool keep_acc(const Unit&) const { return false; }
    __device__ __forceinline__ void init(f32x4 (&acc)[2][2][4][2], const Unit&, int, int, int, int) const {
#pragma unroll
        for (int a = 0; a < 2; ++a)
#pragma unroll
            for (int b = 0; b < 2; ++b)
#pragma unroll
                for (int m = 0; m < 4; ++m)
#pragma unroll
                    for (int n = 0; n < 2; ++n) acc[a][b][m][n] = (f32x4){0.f, 0.f, 0.f, 0.f};
    }
    __device__ __forceinline__ void operator()(f32x4 (&acc)[2][2][4][2], const Unit& u, int wr, int wc, int fr, int fq) const {
        const LAS int* lt = ltab + (u.aux >> 16) * 256;
        const int col0 = u.pn * 256 + wc * 32 + 8 * fq;
        int trow[2][4];
#pragma unroll
        for (int ai = 0; ai < 2; ++ai)
#pragma unroll
            for (int m = 0; m < 4; ++m) { const int li = lt[ai * 128 + wr * 64 + m * 16 + fr]; trow[ai][m] = li >= 0 ? tok[li] : -1; }
#pragma unroll
        for (int ai = 0; ai < 2; ++ai)
#pragma unroll
            for (int m = 0; m < 4; ++m) {
                const int t = trow[ai][m];
                if (t >= 0) {
                    bf16* yp = Y2 + (size_t)t * D + col0;
#pragma unroll
                    for (int bj = 0; bj < 2; ++bj) { const f32x4 v0 = acc[ai][bj][m][0], v1 = acc[ai][bj][m][1];
                        v4u w; w.x = pk2(v0[0], v0[1]); w.y = pk2(v0[2], v0[3]); w.z = pk2(v1[0], v1[1]); w.w = pk2(v1[2], v1[3]);
                        *(v4u*)(yp + bj * 128) = w; }
                }
            }
    }
};

#define XB_TMO      128
#define XB_XCNT(j)  (256  + 64 * (j))
#define XB_XSUB(j)  (1280 + 64 * (j))
#define XB_XGEN(j)  (2304 + 64 * (j))
#define XB_TOP      3328
#define XB_TOPGEN   3392
#define XCD_BAR_WORDS 3456
#define XB_SPIN_CAP (1u << 18)

__device__ __forceinline__ unsigned xb_ld(unsigned* p)              { return __hip_atomic_load((gu32*)p, __ATOMIC_RELAXED, __HIP_MEMORY_SCOPE_AGENT); }
__device__ __forceinline__ unsigned xb_add(unsigned* p, unsigned v) { return __hip_atomic_fetch_add((gu32*)p, v, __ATOMIC_RELAXED, __HIP_MEMORY_SCOPE_AGENT); }
__device__ __forceinline__ unsigned xb_xcc_id() { return (unsigned)__builtin_amdgcn_s_getreg((3 << 11) | 20) & 0xFu; }
#define XB_SPIN(cond, bar) do { unsigned _sp = 0; while (cond) { __builtin_amdgcn_s_sleep(1); \
    if ((++_sp & 255u) == 0u) { if (xb_ld(&(bar)[XB_TMO])) break; if (_sp > XB_SPIN_CAP) { (void)xb_add(&(bar)[XB_TMO], 1u); break; } } } } while (0)

struct XcdBarrier {
    unsigned* bar; unsigned x;
    volatile LAS unsigned* st;
};
__device__ __forceinline__ XcdBarrier xcd_barrier_post(unsigned* bar, volatile LAS unsigned* st) {
    XcdBarrier b; b.bar = bar; b.x = xb_xcc_id(); b.st = st;
    if (threadIdx.x == 0) (void)xb_add(&bar[XB_XCNT(b.x)], 1u);
    return b;
}
__device__ __forceinline__ void xcd_barrier_complete(unsigned* bar, unsigned x, unsigned& nloc, unsigned& nx) {
    const unsigned G = gridDim.x * gridDim.y * gridDim.z;
    unsigned sum, cnt, mine, sp = 0u;
    for (;;) {
        sum = 0u; cnt = 0u; mine = 0u;
#pragma unroll
        for (unsigned j = 0; j < 16; ++j) { const unsigned c = xb_ld(&bar[XB_XCNT(j)]); sum += c; cnt += (c > 0u) ? 1u : 0u; mine = (j == x) ? c : mine; }
        if (sum == G) break;
        __builtin_amdgcn_s_sleep(1);
        if ((++sp & 255u) == 0u) { if (xb_ld(&bar[XB_TMO])) break; if (sp > XB_SPIN_CAP) { (void)xb_add(&bar[XB_TMO], 1u); break; } }
    }
    nloc = mine > 0u ? mine : 1u; nx = cnt > 0u ? cnt : 1u;
}
__device__ __forceinline__ void xcd_barrier(const XcdBarrier& b) {
    asm volatile("s_waitcnt vmcnt(0)" ::: "memory");
    __syncthreads();
    if (threadIdx.x == 0) {
        unsigned* bar = b.bar; unsigned bx_ = b.x;
        asm volatile("" : "+s"(bar), "+s"(bx_));
        __builtin_amdgcn_s_waitcnt(0);
        unsigned nloc = b.st[0], nx = b.st[1];
        if (nloc == 0u) { xcd_barrier_complete(bar, bx_, nloc, nx); b.st[0] = nloc; b.st[1] = nx; }
        const unsigned old = xb_add(&bar[XB_XSUB(bx_)], 1u);
        const unsigned gen = old / nloc;
        if (old + 1u == (gen + 1u) * nloc) {
            __builtin_amdgcn_fence(__ATOMIC_RELEASE, "agent");
            asm volatile("s_waitcnt vmcnt(0)" ::: "memory");
            const unsigned og = xb_add(&bar[XB_TOP], 1u);
            const unsigned tg = og / nx;
            if (og + 1u == (tg + 1u) * nx) xb_add(&bar[XB_TOPGEN], 1u);
            else XB_SPIN(xb_ld(&bar[XB_TOPGEN]) == tg, bar);
            __builtin_amdgcn_fence(__ATOMIC_ACQUIRE, "agent");
            xb_add(&bar[XB_XGEN(bx_)], 1u);
            asm volatile("s_waitcnt vmcnt(0)" ::: "memory");
        } else {
            XB_SPIN(xb_ld(&bar[XB_XGEN(bx_)]) == gen, bar);
            __builtin_amdgcn_fence(__ATOMIC_ACQUIRE, "agent");
            asm volatile("s_waitcnt vmcnt(0)" ::: "memory");
        }
    }
    __syncthreads();
}

__device__ __forceinline__ float wave_sum(float v) {
#pragma unroll
    for (int o = 1; o < 64; o <<= 1) v += __shfl_xor(v, o);
    return v;
}
struct Args { const float* in[17]; float* out; unsigned char* ws; int ph_lo, ph_hi, li, pad; };
struct CvtItem { const float* W; bf16* WT; int K, N, k0, n0, drow0; };
enum { CVT_WIN = 0, CVT_S = 1, CVT_GU = 2, CVT_B = 3 };
__device__ __forceinline__ int cvt_count(int list) { return list == CVT_WIN ? 64 * 136 : list == CVT_S ? (1024 + 1024 + 2048) : list == CVT_GU ? 2 * 16384 : 16384; }
__device__ __forceinline__ CvtItem cvt_decode(const Args& a, int list, int l, int it) {
    CvtItem c; unsigned char* wl = a.ws + WS_WL + (size_t)l * WL_STRIDE;
    if (list == CVT_WIN) { const int kb = it / 136, nb = it - kb * 136; c.W = a.in[2] + (size_t)l * D * INC; c.WT = (bf16*)(wl + WL_IN); c.K = D; c.N = INC; c.k0 = 32 * kb; c.n0 = 64 * nb; c.drow0 = c.n0; return c; }
    if (list == CVT_B) { const int e = it >> 9, q = it & 511, kb = q >> 5, nb = q & 31; c.W = a.in[15] + ((size_t)l * NE + e) * FF * D; c.WT = (bf16*)(wl + WL_D) + (size_t)e * D * FF; c.K = FF; c.N = D; c.k0 = 32 * kb; c.n0 = 64 * nb; c.drow0 = c.n0; return c; }
    int r = it;
    if (list == CVT_S) {
    if (r < 1024) { c.W = a.in[4] + (size_t)l * 1024 * D; c.WT = (bf16*)(wl + WL_A); c.K = 1024; c.N = D; c.k0 = 32 * (r >> 5); c.n0 = 64 * (r & 31); c.drow0 = c.n0; return c; } r -= 1024;
    if (r < 1024) { c.W = a.in[6] + (size_t)l * 1024 * D; c.WT = (bf16*)(wl + WL_C); c.K = 1024; c.N = D; c.k0 = 32 * (r >> 5); c.n0 = 64 * (r & 31); c.drow0 = c.n0; return c; } r -= 1024;
    { c.W = a.in[7] + (size_t)l * D * D; c.WT = (bf16*)(wl + WL_O); c.K = D; c.N = D; c.k0 = 32 * (r >> 5); c.n0 = 64 * (r & 31); c.drow0 = c.n0; return c; }
    }
    const int up = r >= 16384; if (up) r -= 16384;
    const int e = r >> 9, q = r & 511, kb = q >> 3, nb = q & 7;
    c.W = a.in[up ? 14 : 13] + ((size_t)l * NE + e) * D * FF; c.WT = (bf16*)(wl + WL_GU) + (size_t)e * 1024 * D; c.K = D; c.N = FF; c.k0 = 32 * kb; c.n0 = 64 * nb;
    c.drow0 = (c.n0 >> 7) * 256 + (c.n0 & 127) + (up ? 128 : 0); return c;
}
__device__ __forceinline__ void cvt_load(f32x4 (&v)[8], const CvtItem& c, int lane) {
    const float* p = c.W + (size_t)(c.k0 + (lane >> 4)) * c.N + c.n0 + (lane & 15) * 4;
#pragma unroll
    for (int i = 0; i < 8; ++i) v[i] = __builtin_nontemporal_load((const f32x4*)(p + (size_t)(4 * i) * c.N));
}
__device__ __forceinline__ void cvt_emit(const f32x4 (&v)[8], const CvtItem& cur, LAS float* scr, int lane) {
    const int lr = lane >> 4, lc = (lane & 15) * 4, c8 = (lane & 3) * 8, nr = lane >> 2;
#pragma unroll
    for (int i = 0; i < 8; ++i) { LAS float* d = scr + (4 * i + lr) * 65 + lc; d[0] = v[i].x; d[1] = v[i].y; d[2] = v[i].z; d[3] = v[i].w; }
    LDS_WAIT(); asm volatile("" ::: "memory");
#pragma unroll
    for (int jj = 0; jj < 4; ++jj) { const int n = nr + 16 * jj; const LAS float* s = scr + c8 * 65 + n;
        v4u o; o.x = pk2(s[0 * 65], s[1 * 65]); o.y = pk2(s[2 * 65], s[3 * 65]); o.z = pk2(s[4 * 65], s[5 * 65]); o.w = pk2(s[6 * 65], s[7 * 65]);
        __builtin_nontemporal_store(o, (GAS v4u*)(cur.WT + (size_t)(cur.drow0 + n) * cur.K + cur.k0 + c8)); }
    LDS_WAIT(); asm volatile("" ::: "memory");
}
__device__ __forceinline__ void cvt_run(const Args& a, int list, int l, int w, int nw, LAS float* scr, int lane, int it_lo = 0, int it_hi = 1 << 30, int pace = 0) {
    const int T = cvt_count(list) < it_hi ? cvt_count(list) : it_hi;
    int it = it_lo + w;
    CvtItem cA, cB, cC; f32x4 vA[8], vB[8], vC[8];
    bool hA = it < T, hB, hC;
    if (hA) { cA = cvt_decode(a, list, l, it); cvt_load(vA, cA, lane); } it += nw;
    hB = it < T; if (hB) { cB = cvt_decode(a, list, l, it); cvt_load(vB, cB, lane); } it += nw;
    while (hA) {
        hC = it < T; if (hC) { cC = cvt_decode(a, list, l, it); cvt_load(vC, cC, lane); } it += nw;
        cvt_emit(vA, cA, scr, lane); for (int z = 0; z < pace; ++z) __builtin_amdgcn_s_sleep(32);
        if (!hB) break;
        hA = it < T; if (hA) { cA = cvt_decode(a, list, l, it); cvt_load(vA, cA, lane); } it += nw;
        cvt_emit(vB, cB, scr, lane); for (int z = 0; z < pace; ++z) __builtin_amdgcn_s_sleep(32);
        if (!hC) break;
        hB = it < T; if (hB) { cB = cvt_decode(a, list, l, it); cvt_load(vB, cB, lane); } it += nw;
        cvt_emit(vC, cC, scr, lane); for (int z = 0; z < pace; ++z) __builtin_amdgcn_s_sleep(32);
    }
}
__device__ __forceinline__ void norm_row(const float* xrow, const bf16* y0, const bf16* y1, float* xo, const float* g, bf16* hb, float* of, int lane) {
    f32x4 v[8]; float s = 0.f;
#pragma unroll
    for (int j = 0; j < 8; ++j) { v[j] = ((const f32x4*)xrow)[lane + 64 * j]; }
    if (y0) {
        v2u a0[8], a1[8];
#pragma unroll
        for (int j = 0; j < 8; ++j) { a0[j] = ((const v2u*)y0)[lane + 64 * j]; a1[j] = ((const v2u*)y1)[lane + 64 * j]; }
#pragma unroll
        for (int j = 0; j < 8; ++j) { v[j].x += bflo(a0[j].x); v[j].y += bfhi(a0[j].x); v[j].z += bflo(a0[j].y); v[j].w += bfhi(a0[j].y); }
#pragma unroll
        for (int j = 0; j < 8; ++j) { v[j].x += bflo(a1[j].x); v[j].y += bfhi(a1[j].x); v[j].z += bflo(a1[j].y); v[j].w += bfhi(a1[j].y); }
    }
#pragma unroll
    for (int j = 0; j < 8; ++j) s += (v[j].x * v[j].x + v[j].y * v[j].y) + (v[j].z * v[j].z + v[j].w * v[j].w);
    if (xo) {
#pragma unroll
        for (int j = 0; j < 8; ++j) ((f32x4*)xo)[lane + 64 * j] = v[j];
    }
    const float rstd = 1.0f / sqrtf(wave_sum(s) * (1.f / D) + NORM_EPS);
#pragma unroll
    for (int j = 0; j < 8; ++j) {
        const f32x4 gg = ((const f32x4*)g)[lane + 64 * j];
        const f32x4 o = v[j] * rstd * gg;
        if (hb) { v2u w; w.x = pk2(o.x, o.y); w.y = pk2(o.z, o.w); ((v2u*)hb)[lane + 64 * j] = w; }
        else ((f32x4*)of)[lane + 64 * j] = o;
    }
}


__device__ __forceinline__ void phase_prologue(const Args& a, LAS unsigned char* lds, int vcu, int G, int wave, int lane) {
    unsigned char* ws = a.ws;
    LAS float* scr = (LAS float*)(lds + wave * 16384);
    const int gw = vcu * NWAVES + wave, NGW = G * NWAVES;
    cvt_run(a, CVT_WIN, 0, gw, NGW, scr, lane); cvt_run(a, CVT_S, 0, gw, NGW, scr, lane);
    const int gt = gw * 64 + lane, NGT = NGW * 64;
    for (int idx = gt; idx < DEPTH * 48 * D; idx += NGT) {
        const int l = idx / (48 * D), rem = idx - l * 48 * D, n = rem / D, k = rem - n * D;
        float w = 0.f; if (n < 4) w = a.in[9][((size_t)l * D + k) * 4 + n]; else if (n < 36) w = a.in[11][((size_t)l * D + k) * 32 + (n - 4)];
        const unsigned hi = f2bf(w); const float lo = w - __builtin_bit_cast(float, hi << 16);
        bf16* wr = (bf16*)(ws + WS_WL + (size_t)l * WL_STRIDE + WL_R);
        wr[n * D + k] = (bf16)hi; wr[48 * D + n * D + k] = (bf16)f2bf(lo);
    }
    for (int idx = gt; idx < SEQ * 8; idx += NGT) {
        const int pos = idx >> 3, i = idx & 7;
        const float inv = i == 0 ? 1.0f : i == 1 ? 0x1.8d275ep-3f : i == 2 ? 0x1.341190p-5f : i == 3 ? 0x1.ddee9cp-8f : i == 4 ? 0x1.72ba44p-10f : i == 5 ? 0x1.1f91f0p-12f : i == 6 ? 0x1.be2188p-15f : 0x1.5a0f4ep-17f;
        const float ang = (float)pos * inv;
        const double ad = (double)ang, kq = __builtin_rint(ad * 0.63661977236758134308);
        const double rr = __builtin_fma(-kq, 1.5707963267948966192, ad) - kq * 6.123233995736766e-17, r2 = rr * rr;
        const double sp = rr * (1.0 + r2 * (-1.0 / 6 + r2 * (1.0 / 120 + r2 * (-1.0 / 5040 + r2 * (1.0 / 362880 + r2 * (-1.0 / 39916800 + r2 * (1.0 / 6227020800.0)))))));
        const double cp = 1.0 + r2 * (-0.5 + r2 * (1.0 / 24 + r2 * (-1.0 / 720 + r2 * (1.0 / 40320 + r2 * (-1.0 / 3628800 + r2 * (1.0 / 479001600.0 + r2 * (-1.0 / 87178291200.0)))))));
        const int qd = (int)kq & 3;
        const double sn = qd == 0 ? sp : qd == 1 ? cp : qd == 2 ? -sp : -cp, cs = qd == 0 ? cp : qd == 1 ? -sp : qd == 2 ? -cp : sp;
        float* rp = (float*)(ws + WS_ROPE) + (size_t)pos * 16;
        rp[i] = (float)cs; rp[8 + i] = (float)sn;
    }
    for (int m = gw; m < M; m += NGW) norm_row(a.in[0] + (size_t)m * D, nullptr, nullptr, nullptr, a.in[1], (bf16*)(ws + WS_H) + (size_t)m * D, nullptr, lane);
}

constexpr int KS_STRIDE = 144, VT_OFF = 256 * KS_STRIDE, VT_STRIDE = 520;
__device__ __forceinline__ int crow(int r, int hi) { return (r & 3) + 8 * (r >> 2) + 4 * hi; }
__device__ __forceinline__ void attn_side_work(const Args& a, int l, LAS unsigned char* lds, int G, int vcu, int wave, int lane, int gu_lo);
__device__ __forceinline__ void phase_attn_conv(const Args& a, int l, LAS unsigned char* lds, int G, int vcu, int tid, int wave, int lane, int gu_lo) {
#define side_work() attn_side_work(a, l, lds, G, vcu, wave, lane, gu_lo)
    unsigned char* ws = a.ws;
    const bf16* P = (const bf16*)(ws + WS_P);
    bf16* AO = (bf16*)(ws + WS_AO);
    const float* sinks = a.in[3] + l * 16;
    const int j = lane & 31, h = lane >> 5;
    constexpr float LOG2E = 1.4426950408889634f;
    {   const int unit = blockIdx.x;
        const int qb = unit & 31, kvh = (unit >> 5) & 3, b = unit >> 7;
        const int q0 = qb * 128; const size_t rowbase = (size_t)b * SEQ;
#pragma unroll
        for (int it = 0; it < 4; ++it) {
            const int idx = it * 512 + tid, kl = idx >> 3, ch = idx & 7, pos = q0 - 128 + kl;
            v4u kv = {0u, 0u, 0u, 0u}, vv = kv;
            if (pos >= 0) { const bf16* src = P + (rowbase + pos) * INC + kvh * 64 + ch * 8; kv = *(const v4u*)(src + C_K); vv = *(const v4u*)(src + C_V); }
            *(LAS v4u*)(lds + kl * KS_STRIDE + ch * 16) = kv;
            LAS unsigned short* vt = (LAS unsigned short*)(lds + VT_OFF + (ch * 8) * VT_STRIDE + kl * 2);
            vt[0 * (VT_STRIDE / 2)] = (unsigned short)(vv.x & 0xffffu); vt[1 * (VT_STRIDE / 2)] = (unsigned short)(vv.x >> 16);
            vt[2 * (VT_STRIDE / 2)] = (unsigned short)(vv.y & 0xffffu); vt[3 * (VT_STRIDE / 2)] = (unsigned short)(vv.y >> 16);
            vt[4 * (VT_STRIDE / 2)] = (unsigned short)(vv.z & 0xffffu); vt[5 * (VT_STRIDE / 2)] = (unsigned short)(vv.z >> 16);
            vt[6 * (VT_STRIDE / 2)] = (unsigned short)(vv.w & 0xffffu); vt[7 * (VT_STRIDE / 2)] = (unsigned short)(vv.w >> 16);
        }
        __syncthreads();
        if (wave >= 4) side_work();
        else
#pragma unroll 1
        for (int tk = 0; tk < 4; ++tk) {
            const int task = wave + 4 * tk, hql = task >> 2, sub = task & 3, r0 = sub * 32, head = kvh * 4 + hql;
            const bf16* qrow = P + (rowbase + q0 + r0 + j) * INC + C_Q + head * 64 + h * 8;
            bf16x8 qf[4];
#pragma unroll
            for (int c = 0; c < 4; ++c) qf[c] = *(const bf16x8*)(qrow + 16 * c);
            f32x16 s[5];
#pragma unroll
            for (int kbi = 0; kbi < 5; ++kbi) {
                const int kl0 = 32 * (sub + kbi);
                f32x16 acc = {0.f, 0.f, 0.f, 0.f, 0.f, 0.f, 0.f, 0.f, 0.f, 0.f, 0.f, 0.f, 0.f, 0.f, 0.f, 0.f};
#pragma unroll
                for (int c = 0; c < 4; ++c) {
                    const bf16x8 kf = *(const LAS bf16x8*)(lds + (kl0 + j) * KS_STRIDE + (16 * c + 8 * h) * 2);
                    acc = __builtin_amdgcn_mfma_f32_32x32x16_bf16(kf, qf[c], acc, 0, 0, 0);
                }
                s[kbi] = acc;
                __builtin_amdgcn_sched_barrier(0);
            }
            const float sink = sinks[head] * LOG2E;
            float mx = sink;
#pragma unroll
            for (int kbi = 0; kbi < 5; ++kbi) {
                const int base = (qb == 0 && sub + kbi < 4) ? -4096 : (j + 128 - 32 * kbi - 4 * h);
#pragma unroll
                for (int i = 0; i < 16; ++i) {
                    const int dd = base - ((i & 3) + 8 * (i >> 2)), tt = min(dd, 127 - dd);
                    const float pen = __builtin_bit_cast(float, 0x7f800000u | ((unsigned)(tt >> 31) & 0x80000000u));
                    const float v = __builtin_fminf(s[kbi][i] * LOG2E, pen); s[kbi][i] = v; mx = __builtin_fmaxf(mx, v);
                }
            }
            mx = __builtin_fmaxf(mx, __shfl_xor(mx, 32));
            float lsum = 0.f;
#pragma unroll
            for (int kbi = 0; kbi < 5; ++kbi)
#pragma unroll
                for (int i = 0; i < 16; ++i) { const float p = __builtin_amdgcn_exp2f(s[kbi][i] - mx); s[kbi][i] = p; lsum += p; }
            lsum += __shfl_xor(lsum, 32);
            lsum += __builtin_amdgcn_exp2f(sink - mx);
            f32x16 o[2];
#pragma unroll
            for (int db = 0; db < 2; ++db) o[db] = (f32x16){0.f, 0.f, 0.f, 0.f, 0.f, 0.f, 0.f, 0.f, 0.f, 0.f, 0.f, 0.f, 0.f, 0.f, 0.f, 0.f};
#pragma unroll
            for (int kbi = 0; kbi < 5; ++kbi)
#pragma unroll
                for (int st = 0; st < 2; ++st) {
                    v4u pw; pw.x = pk2i(s[kbi][8 * st + 0], s[kbi][8 * st + 1]); pw.y = pk2i(s[kbi][8 * st + 2], s[kbi][8 * st + 3]);
                    pw.z = pk2i(s[kbi][8 * st + 4], s[kbi][8 * st + 5]); pw.w = pk2i(s[kbi][8 * st + 6], s[kbi][8 * st + 7]);
                    const bf16x8 pf = __builtin_bit_cast(bf16x8, pw);
#pragma unroll
                    for (int db = 0; db < 2; ++db) {
                        const int addr = VT_OFF + (32 * db + j) * VT_STRIDE + (32 * (sub + kbi) + 16 * st + 4 * h) * 2;
                        const s16x4 lo = *(const LAS s16x4*)(lds + addr), hi = *(const LAS s16x4*)(lds + addr + 16);
                        const bf16x8 vf = __builtin_shufflevector(lo, hi, 0, 1, 2, 3, 4, 5, 6, 7);
                        o[db] = __builtin_amdgcn_mfma_f32_32x32x16_bf16(vf, pf, o[db], 0, 0, 0);
                    }
                    __builtin_amdgcn_sched_barrier(0);
                }
            const float inv = 1.0f / lsum;
            bf16* orow = AO + (rowbase + q0 + r0 + j) * 1024 + head * 64 + 4 * h;
#pragma unroll
            for (int db = 0; db < 2; ++db)
#pragma unroll
                for (int g = 0; g < 4; ++g) {
                    v2u w; w.x = pk2i(o[db][4 * g + 0] * inv, o[db][4 * g + 1] * inv); w.y = pk2i(o[db][4 * g + 2] * inv, o[db][4 * g + 3] * inv);
                    *(v2u*)(orow + 32 * db + 8 * g) = w;
                }
        }
        __syncthreads();
    }
}
__device__ __forceinline__ void attn_side_work(const Args& a, int l, LAS unsigned char* lds, int G, int vcu, int wave, int lane_in, int gu_lo) {
    int lane = lane_in; asm volatile("" : "+v"(lane));
    unsigned char* ws = a.ws;
    const bf16* P = (const bf16*)(ws + WS_P);
    bf16* CV = (bf16*)(ws + WS_CV);
    const float* cw = a.in[5] + (size_t)l * 3 * 1024;
    for (int it = blockIdx.x * 256 + (wave - 4) * 64 + lane; it < 1024 * 128; it += G * 256) {
        const int ch = it & 127, t0 = (it >> 7) * 8, c0 = ch * 8;
        float w0[8], w1[8], w2[8], u1[8], u2[8];
#pragma unroll
        for (int e = 0; e < 8; ++e) { w0[e] = cw[c0 + e]; w1[e] = cw[1024 + c0 + e]; w2[e] = cw[2048 + c0 + e]; u1[e] = 0.f; u2[e] = 0.f; }
        if ((t0 & (SEQ - 1)) != 0) {
            const bf16* p2 = P + (size_t)(t0 - 2) * INC + c0; const bf16* p1 = p2 + INC;
            const v4u c2 = *(const v4u*)(p2 + C_CC), x2 = *(const v4u*)(p2 + C_CX), c1 = *(const v4u*)(p1 + C_CC), x1 = *(const v4u*)(p1 + C_CX);
            u2[0] = bflo(c2.x) * bflo(x2.x); u2[1] = bfhi(c2.x) * bfhi(x2.x); u2[2] = bflo(c2.y) * bflo(x2.y); u2[3] = bfhi(c2.y) * bfhi(x2.y);
            u2[4] = bflo(c2.z) * bflo(x2.z); u2[5] = bfhi(c2.z) * bfhi(x2.z); u2[6] = bflo(c2.w) * bflo(x2.w); u2[7] = bfhi(c2.w) * bfhi(x2.w);
            u1[0] = bflo(c1.x) * bflo(x1.x); u1[1] = bfhi(c1.x) * bfhi(x1.x); u1[2] = bflo(c1.y) * bflo(x1.y); u1[3] = bfhi(c1.y) * bfhi(x1.y);
            u1[4] = bflo(c1.z) * bflo(x1.z); u1[5] = bfhi(c1.z) * bfhi(x1.z); u1[6] = bflo(c1.w) * bflo(x1.w); u1[7] = bfhi(c1.w) * bfhi(x1.w);
        }
#pragma unroll
        for (int t = 0; t < 8; ++t) {
            const bf16* pp = P + (size_t)(t0 + t) * INC + c0;
            const v4u cc = *(const v4u*)(pp + C_CC), cx = *(const v4u*)(pp + C_CX), cb = *(const v4u*)(pp + C_CB);
            float u0[8], bb[8], y[8];
            u0[0] = bflo(cc.x) * bflo(cx.x); u0[1] = bfhi(cc.x) * bfhi(cx.x); u0[2] = bflo(cc.y) * bflo(cx.y); u0[3] = bfhi(cc.y) * bfhi(cx.y);
            u0[4] = bflo(cc.z) * bflo(cx.z); u0[5] = bfhi(cc.z) * bfhi(cx.z); u0[6] = bflo(cc.w) * bflo(cx.w); u0[7] = bfhi(cc.w) * bfhi(cx.w);
            bb[0] = bflo(cb.x); bb[1] = bfhi(cb.x); bb[2] = bflo(cb.y); bb[3] = bfhi(cb.y); bb[4] = bflo(cb.z); bb[5] = bfhi(cb.z); bb[6] = bflo(cb.w); bb[7] = bfhi(cb.w);
#pragma unroll
            for (int e = 0; e < 8; ++e) { y[e] = bb[e] * (w0[e] * u2[e] + w1[e] * u1[e] + w2[e] * u0[e]); u2[e] = u1[e]; u1[e] = u0[e]; }
            v4u o; o.x = pk2(y[0], y[1]); o.y = pk2(y[2], y[3]); o.z = pk2(y[4], y[5]); o.w = pk2(y[6], y[7]);
            *(v4u*)(CV + (size_t)(t0 + t) * 1024 + c0) = o;
        }
    }
    cvt_run(a, CVT_GU, l, vcu * 4 + (wave - 4), G * 4, (LAS float*)(lds + 81920 + (wave - 4) * 8704), lane, gu_lo, GU_SPLIT2);
}

__device__ __forceinline__ void phase_norm_router(const Args& a, int l, LAS unsigned char* lds, int G, int vcu, int tid, int wave, int lane, int bank) {
    unsigned char* ws = a.ws;
    const bf16* HX = (const bf16*)(ws + WS_H);
    const float* part = (const float*)(ws + WS_PART);
    const bf16* Wh = (const bf16*)(ws + WS_WL + (size_t)l * WL_STRIDE + WL_R); const bf16* Wl = Wh + 48 * D;
    const float* bg = a.in[10] + l * 4; const float* br = a.in[12] + l * 32;
    unsigned* cnt = (unsigned*)(ws + WS_CTL) + CW_CNT + l * 256 + bank * 512 + (blockIdx.x & 7) * 32;
    int* tok = (int*)(ws + WS_TOK); float* wgt = (float*)(ws + WS_WGT); float* rsl = (float*)(ws + WS_RSL);
    LAS float* red = (LAS float*)lds;
    LAS float* lg = (LAS float*)(lds + 49152);
    LAS float* rs = (LAS float*)(lds + 49152 + 6144);
    const int r = lane & 15, q = lane >> 4;
    {   const int blk = blockIdx.x;
        const int row0 = blk * 32;
        if (tid < 32) { const f32x4* pp = (const f32x4*)(part + (size_t)(row0 + tid) * 32); float t = 0.f;
#pragma unroll
            for (int i = 0; i < 8; ++i) { const f32x4 v = pp[i]; t += (v.x + v.y) + (v.z + v.w); }
            rs[tid] = 1.0f / sqrtf(t * (1.f / D) + NORM_EPS); }
        bf16x8 xa[2][8];
#pragma unroll
        for (int rg = 0; rg < 2; ++rg)
#pragma unroll
            for (int jj = 0; jj < 8; ++jj) xa[rg][jj] = *(const bf16x8*)(HX + (size_t)(row0 + 16 * rg + r) * D + 256 * wave + 32 * jj + 8 * q);
        f32x4 acc[2][3];
#pragma unroll
        for (int rg = 0; rg < 2; ++rg)
#pragma unroll
            for (int cb = 0; cb < 3; ++cb) acc[rg][cb] = (f32x4){0.f, 0.f, 0.f, 0.f};
#pragma unroll
        for (int hb = 0; hb < 8 / RB; ++hb) {
            bf16x8 wh[RB][3], wl[RB][3];
#pragma unroll
            for (int j2 = 0; j2 < RB; ++j2)
#pragma unroll
                for (int cb = 0; cb < 3; ++cb) { const size_t o = (size_t)(16 * cb + r) * D + 256 * wave + 32 * (RB * hb + j2) + 8 * q; wh[j2][cb] = *(const bf16x8*)(Wh + o); wl[j2][cb] = *(const bf16x8*)(Wl + o); }
            __builtin_amdgcn_sched_barrier(0);
#pragma unroll
            for (int j2 = 0; j2 < RB; ++j2)
#pragma unroll
                for (int cb = 0; cb < 3; ++cb)
#pragma unroll
                    for (int rg = 0; rg < 2; ++rg) {
                        acc[rg][cb] = __builtin_amdgcn_mfma_f32_16x16x32_bf16(wh[j2][cb], xa[rg][RB * hb + j2], acc[rg][cb], 0, 0, 0);
                        acc[rg][cb] = __builtin_amdgcn_mfma_f32_16x16x32_bf16(wl[j2][cb], xa[rg][RB * hb + j2], acc[rg][cb], 0, 0, 0);
                    }
            __builtin_amdgcn_sched_barrier(0);
        }
#pragma unroll
        for (int rg = 0; rg < 2; ++rg)
#pragma unroll
            for (int cb = 0; cb < 3; ++cb) *(LAS f32x4*)(red + (wave * 32 + 16 * rg + r) * 48 + 16 * cb + 4 * q) = acc[rg][cb];
        __syncthreads();
        for (int idx = tid; idx < 32 * 48; idx += 512) { float t = 0.f;
#pragma unroll
            for (int w = 0; w < 8; ++w) t += red[w * 1536 + idx];
            lg[idx] = t; }
        __syncthreads();
        if (wave >= 1) { int ln = lane; asm volatile("" : "+v"(ln)); cvt_run(a, CVT_GU, l, vcu * 7 + (wave - 1), G * 7, (LAS float*)(lds + 65536 + (wave - 1) * 8704), ln, GU_SPLIT2, 1 << 30); }
        if (tid < 32) {
            const float rsd = rs[tid]; const LAS float* lr = lg + tid * 48;
            float gl0 = lr[0] * rsd + bg[0], gl1 = lr[1] * rsd + bg[1], gl2 = lr[2] * rsd + bg[2], gl3 = lr[3] * rsd + bg[3];
            int gi = 0; float gm = gl0;
            if (gl1 > gm) { gm = gl1; gi = 1; } if (gl2 > gm) { gm = gl2; gi = 2; } if (gl3 > gm) { gm = gl3; gi = 3; }
            const float gw = 1.0f / (__expf(gl0 - gm) + __expf(gl1 - gm) + __expf(gl2 - gm) + __expf(gl3 - gm));
            float sv[8];
#pragma unroll
            for (int e = 0; e < 8; ++e) sv[e] = lr[4 + gi * 8 + e] * rsd + br[gi * 8 + e];
            int i1 = 0; float m1 = sv[0];
#pragma unroll
            for (int e = 1; e < 8; ++e) if (sv[e] > m1) { m1 = sv[e]; i1 = e; }
            int i2 = (i1 + 1) & 7; float m2 = -INFINITY;
#pragma unroll
            for (int e = 0; e < 8; ++e) if (e != i1 && sv[e] > m2) { m2 = sv[e]; i2 = e; }
            const float p2 = __expf(m2 - m1), w1 = gw / (1.0f + p2), w2 = gw * p2 / (1.0f + p2);
            const int e1 = gi * 8 + i1, e2 = gi * 8 + i2, token = row0 + tid;
            const unsigned pos1 = __hip_atomic_fetch_add(cnt + e1, 1u, RLX_AGENT), pos2 = __hip_atomic_fetch_add(cnt + e2, 1u, RLX_AGENT);
            const int li1 = e1 * M + (blockIdx.x & 7) * SHARD_CAP + (int)pos1, li2 = e2 * M + (blockIdx.x & 7) * SHARD_CAP + (int)pos2;
            tok[li1] = token * 2; wgt[li1] = w1; rsl[li1] = rsd;
            tok[li2] = token * 2 + 1; wgt[li2] = w2; rsl[li2] = rsd;
        }
        __syncthreads();
    }
}

__device__ __forceinline__ int slot_index(const LAS int* sp, int e, int pos) {
    int sh = 0;
#pragma unroll
    for (int k = 1; k < NSHARD; ++k) sh += (pos >= sp[e * 9 + k]) ? 1 : 0;
    return e * M + sh * SHARD_CAP + pos - sp[e * 9 + sh];
}
__device__ __forceinline__ int moe_tables(const Args& a, int l, LAS unsigned char* lds, int tid) {
    LAS int* tile_e = (LAS int*)(lds + TILE_OFF); LAS int* tile_mt = tile_e + 128; LAS int* lcnt = tile_e + 256; LAS int* lnt = tile_e + 288;
    const unsigned* cnt = (const unsigned*)(a.ws + WS_CTL) + CW_CNT + l * 256;
    if (tid < 64) {
        LAS int* sp = tile_e + 320;
        int c = 0;
        if (tid < 32) { unsigned cs[NSHARD];
#pragma unroll
            for (int sh = 0; sh < NSHARD; ++sh) cs[sh] = __hip_atomic_load(cnt + sh * 32 + tid, RLX_AGENT);
            sp[tid * 9] = 0;
#pragma unroll
            for (int sh = 0; sh < NSHARD; ++sh) { c += (int)cs[sh]; sp[tid * 9 + sh + 1] = c; } }
        const int n = (c + 255) >> 8;
        int inc = n;
#pragma unroll
        for (int o = 1; o < 32; o <<= 1) { const int t = __shfl_up(inc, o); if (tid >= o) inc += t; }
        const int start = inc - n;
        if (tid < 32) { lcnt[tid] = c;
#pragma unroll 1
            for (int mt = 0; mt < n; ++mt) { if (start + mt < 128) { tile_e[start + mt] = tid; tile_mt[start + mt] = mt; } } }
        if (tid == 31) lnt[0] = inc < 128 ? inc : 128;
    }
    __syncthreads();
    return lnt[0];
}

__global__ void __launch_bounds__(NWAVES * 64, 2) mk_fwd(Args args) {
    extern __shared__ __attribute__((aligned(16))) unsigned char lds_raw[];
    LAS unsigned char* lds = (LAS unsigned char*)lds_raw;
    volatile LAS unsigned* MISC = (volatile LAS unsigned*)(lds + MISC_OFF);
    const int G = gridDim.x; const int bx = blockIdx.x; const int vcu = (G % 8 == 0) ? (bx % 8) * (G / 8) + bx / 8 : bx;
    unsigned char* ws = args.ws;
    gu32* ctl = (gu32*)(ws + WS_CTL);
    for (int u = threadIdx.x; u < (LDS_BYTES - LDSCTL_OFF) / 4; u += NWAVES * 64) ((LAS unsigned*)(lds + LDSCTL_OFF))[u] = 0u;
    __syncthreads();
    XcdBarrier bar; bar.bar = (unsigned*)ctl + CW_BAR; bar.x = 0; bar.st = nullptr;
    if (MK_N_LAUNCHES == 1) bar = xcd_barrier_post((unsigned*)ctl + CW_BAR, MISC + 8);
#ifndef MK_BAR_REP
#define MK_BAR_REP 1
#endif
#define GRID_BAR() do { if (MK_N_LAUNCHES == 1) { _Pragma("unroll 1") for (int br_ = 0; br_ < MK_BAR_REP; ++br_) xcd_barrier(bar); } } while (0)
#ifndef MK_STRETCH_PH
#define MK_STRETCH_PH -1
#endif
#ifndef MK_STRETCH_MUL
#define MK_STRETCH_MUL 3
#endif
#ifndef MK_STRETCH_ROLE
#define MK_STRETCH_ROLE 0
#endif
#define STRETCH(pid) do { if (MK_STRETCH_PH >= 0 && (pid) == MK_STRETCH_PH && stretch_ok) { asm volatile("s_waitcnt vmcnt(0)" ::: "memory"); if (threadIdx.x == 0) { \
        const unsigned long long t1_ = __builtin_amdgcn_s_memrealtime(), t0_ = (unsigned long long)MISC[16] | ((unsigned long long)MISC[17] << 32), dt_ = (t1_ - t0_) * MK_STRETCH_MUL; \
        while (__builtin_amdgcn_s_memrealtime() - t1_ < dt_) __builtin_amdgcn_s_sleep(8); } } } while (0)
#define STAMP0() do { if (MK_STRETCH_PH >= 0 && threadIdx.x == 0) { const unsigned long long t_ = __builtin_amdgcn_s_memrealtime(); MISC[16] = (unsigned)t_; MISC[17] = (unsigned)(t_ >> 32); } } while (0)
#define GRID_BAR_P(pid) do { STRETCH(pid); GRID_BAR(); STAMP0(); } while (0)
    bool stretch_ok = true; (void)stretch_ok;
    STAMP0();
    const int lo = args.ph_lo, hi = args.ph_hi;
#ifndef PH_MASK
#define PH_MASK 0x1ff
#endif
#define PHON(j) (((PH_MASK) >> (j)) & 1)
#define IN(k) (lo <= (k) && (k) < hi)
#define BOTH(k) (IN(k) && IN((k) + 1))

#define PHASE_IDS() int tid_ = threadIdx.x; asm volatile("" : "+v"(tid_)); const int tid = tid_, lane = tid & 63, wave = __builtin_amdgcn_readfirstlane(tid >> 6); (void)tid; (void)lane; (void)wave
    if (PHON(0) && IN(0)) { PHASE_IDS(); REP(0, true) phase_prologue(args, lds, vcu, G, wave, lane); if (BOTH(0)) GRID_BAR_P(0); }

    constexpr int GU_SPLIT = 22528;
    constexpr int WIN_EARLY = 1536;
    constexpr int NG2 = 218;
    for (int l = 0; l < DEPTH; ++l) {
        const int pb = 1 + 8 * l;
        unsigned char* wl = ws + WS_WL + (size_t)l * WL_STRIDE;
        if (PHON(1) && IN(pb + 0)) {
            PHASE_IDS();
            if (bx >= NG2) { cvt_run(args, CVT_GU, l, (bx - NG2) * NWAVES + wave, (256 - NG2) * NWAVES, (LAS float*)(lds + wave * 16384), lane, 0, GU_SPLIT, MK_PACE2);
                if (l + 1 < DEPTH) cvt_run(args, CVT_WIN, l + 1, (bx - NG2) * NWAVES + wave, (256 - NG2) * NWAVES, (LAS float*)(lds + wave * 16384), lane, 0, WIN_EARLY); }
            if (bx < NG2) {
            SchedPlain S; S.T.init(M, INC, NG2, bx); S.A = (const char*)(ws + WS_H); S.Bt = (const char*)(wl + WL_IN); S.tstep = (size_t)256 * D * 2;
            EpiInProj E{(bf16*)(ws + WS_P), (const float*)(ws + WS_ROPE)};
            REP(1, true) pg8::gemm_phase<EpiInProj, SchedPlain, true, false>(lds, D, S, E);
            }
            if (MK_STRETCH_ROLE) stretch_ok = (MK_STRETCH_ROLE == 1) == (bx < NG2);
            if (BOTH(pb + 0)) GRID_BAR_P(pb + 0); else STRETCH(pb + 0);
            stretch_ok = true;
        }
        if (PHON(2) && IN(pb + 1)) { PHASE_IDS(); REP(2, true) phase_attn_conv(args, l, lds, G, vcu, tid, wave, lane, GU_SPLIT); if (BOTH(pb + 1)) GRID_BAR_P(pb + 1); else STRETCH(pb + 1); }
        if (PHON(3) && IN(pb + 2)) {
            SchedPair S; S.T.init(M, D, G, bx); S.A0 = (const char*)(ws + WS_AO); S.A1 = (const char*)(ws + WS_CV); S.B0 = (const char*)(wl + WL_A); S.B1 = (const char*)(wl + WL_C); S.tstep = (size_t)256 * 1024 * 2;
            EpiMerge E{(const bf16*)(ws + WS_P), (bf16*)(ws + WS_MG)};
            REP(3, true) pg8::gemm_phase<EpiMerge, SchedPair, true, false>(lds, 1024, S, E);
            if (BOTH(pb + 2)) GRID_BAR_P(pb + 2); else STRETCH(pb + 2);
        }
        if (PHON(4) && IN(pb + 3)) {
            SchedPlain S; S.T.init(M, D, G, bx); S.A = (const char*)(ws + WS_MG); S.Bt = (const char*)(wl + WL_O); S.tstep = (size_t)256 * D * 2;
            EpiResHx E{l == 0 ? args.in[0] : (const float*)(ws + WS_XRES), (float*)(ws + WS_XRES), (bf16*)(ws + WS_H), args.in[8] + (size_t)l * D, (float*)(ws + WS_PART)};
            REP(4, l == 0) pg8::gemm_phase<EpiResHx, SchedPlain, true, false>(lds, D, S, E);
            if (BOTH(pb + 3)) GRID_BAR_P(pb + 3); else STRETCH(pb + 3);
        }
        if (PHON(5) && IN(pb + 4)) { PHASE_IDS(); REP(5, true) phase_norm_router(args, l, lds, G, vcu, tid, wave, lane, rep_); if (BOTH(pb + 4)) GRID_BAR_P(pb + 4); else STRETCH(pb + 4); }
        if (PHON(6) && IN(pb + 5)) {
            PHASE_IDS();
            const int ntiles = moe_tables(args, l, lds, tid);
            int NG7; { const int th = (ntiles + 1) >> 1, rounds = (th + 27) / 28, per = (th + rounds - 1) / rounds; NG7 = 8 * per; }
            if (bx >= NG7) { const int cw = (bx - NG7) * NWAVES + wave, cn = (256 - NG7) * NWAVES; LAS float* scr = (LAS float*)(lds + wave * 16384);
                cvt_run(args, CVT_B, l, cw, cn, scr, lane, 0, 1 << 30, MK_PACE7);
                if (l + 1 < DEPTH) { cvt_run(args, CVT_WIN, l + 1, cw, cn, scr, lane, WIN_EARLY, 1 << 30, MK_PACE7 / 2); if ((ntiles * 8 + 223) / 224 != (ntiles * 8 + 255) / 256) cvt_run(args, CVT_S, l + 1, cw, cn, scr, lane); } }
            if (bx < NG7) {
            LAS int* tile_e = (LAS int*)(lds + TILE_OFF); LAS int* tile_mt = tile_e + 128; LAS int* lcnt = tile_e + 256;
            LAS unsigned* gtab = (LAS unsigned*)(lds + GTAB_OFF); LAS int* ltab = (LAS int*)(lds + LTAB_OFF);
            const int* tok = (const int*)(ws + WS_TOK);
            for (int idx = tid; idx < 4 * 256; idx += 512) {
                const int ui = idx >> 8, rr = idx & 255; unsigned off = 0u;
                const int th = (ntiles + 1) >> 1, t = ui * (NG7 >> 3) + (bx >> 3), tile = ((bx & 7) >> 2) * th + t;
                int li = -1;
                if (t < th && tile < ntiles) { const int e = tile_e[tile], pos = tile_mt[tile] * 256 + rr; if (pos < lcnt[e]) { li = slot_index(tile_e + 320, e, pos); off = (unsigned)(tok[li] >> 1) * (unsigned)(D * 2); } }
                gtab[idx] = off; ltab[idx] = li;
            }
            __syncthreads();
            SchedMoe S; S.tile_e = tile_e; S.tile_mt = tile_mt; S.gtab = gtab; S.ntiles = ntiles; S.nN = 4; S.G = NG7; S.c = bx;
            S.A = (const char*)(ws + WS_H); S.Bt = (const char*)(wl + WL_GU); S.a_tstep = 0; S.b_estep = (size_t)1024 * D * 2; S.b_tstep = (size_t)256 * D * 2; S.gather = true;
            EpiMoeGU E{(bf16*)(ws + WS_ACT), (const float*)(ws + WS_WGT), (const float*)(ws + WS_RSL), ltab};
            REP(6, true) pg8::gemm_phase<EpiMoeGU, SchedMoe, true, true>(lds, D, S, E);
            }
            if (MK_STRETCH_ROLE) stretch_ok = (MK_STRETCH_ROLE == 1) == (bx < NG7);
            if (BOTH(pb + 5)) GRID_BAR_P(pb + 5); else STRETCH(pb + 5);
            stretch_ok = true;
        }
        if (PHON(7) && IN(pb + 6)) {
            PHASE_IDS();
            const int ntiles = (MK_N_LAUNCHES == 1) ? ((LAS int*)(lds + TILE_OFF))[288] : moe_tables(args, l, lds, tid);
            const int NG8 = (l + 1 < DEPTH && (ntiles * 8 + 223) / 224 == (ntiles * 8 + 255) / 256) ? 224 : 256;
            if (bx >= NG8 && l + 1 < DEPTH) cvt_run(args, CVT_S, l + 1, (bx - NG8) * NWAVES + wave, (256 - NG8) * NWAVES, (LAS float*)(lds + wave * 16384), lane);
            if (bx < NG8) {
            LAS int* tile_e = (LAS int*)(lds + TILE_OFF); LAS int* tile_mt = tile_e + 128; LAS int* lcnt = tile_e + 256;
            LAS int* ltab = (LAS int*)(lds + LTAB_OFF);
            for (int idx = tid; idx < 4 * 256; idx += 512) {
                const int ui = idx >> 8, rr = idx & 255, L = ui * NG8 + bx; int li = -1;
                if (L < ntiles * 8) { const int tile = L >> 3, e = tile_e[tile], pos = tile_mt[tile] * 256 + rr; if (pos < lcnt[e]) li = slot_index(tile_e + 320, e, pos); }
                ltab[idx] = li;
            }
            __syncthreads();
            SchedMoe S; S.tile_e = tile_e; S.tile_mt = tile_mt; S.gtab = (LAS unsigned*)(lds + GTAB_OFF); S.ntiles = ntiles; S.nN = 8; S.G = NG8; S.c = bx;
            S.A = (const char*)(ws + WS_ACT); S.Bt = (const char*)(wl + WL_D); S.a_tstep = (size_t)256 * FF * 2; S.b_estep = (size_t)D * FF * 2; S.b_tstep = (size_t)256 * FF * 2; S.gather = false;
            EpiMoeDown E{(bf16*)(ws + WS_Y2), (const int*)(ws + WS_TOK), ltab};
            REP(7, true) pg8::gemm_phase<EpiMoeDown, SchedMoe, true, false>(lds, FF, S, E);
            }
            if (BOTH(pb + 6)) GRID_BAR_P(pb + 6); else STRETCH(pb + 6);
        }
        if (PHON(8) && IN(pb + 7)) {
            PHASE_IDS();
            const int gw = vcu * NWAVES + wave, NGW = G * NWAVES;
            float* X = (float*)(ws + WS_XRES); const bf16* Y2 = (const bf16*)(ws + WS_Y2);
            REP(8, l + 1 == DEPTH) for (int m = gw; m < M; m += NGW) {
                if (l + 1 < DEPTH) norm_row(X + (size_t)m * D, Y2 + (size_t)(2 * m) * D, Y2 + (size_t)(2 * m + 1) * D, X + (size_t)m * D, args.in[1] + (size_t)(l + 1) * D, (bf16*)(ws + WS_H) + (size_t)m * D, nullptr, lane);
                else norm_row(X + (size_t)m * D, Y2 + (size_t)(2 * m) * D, Y2 + (size_t)(2 * m + 1) * D, nullptr, args.in[16], nullptr, args.out + (size_t)m * D, lane);
            }
            if (BOTH(pb + 7)) GRID_BAR_P(pb + 7); else STRETCH(pb + 7);
        }
    }
#undef IN
#undef BOTH
}

extern "C" void kernel_launch(void* const* d_in, const int* in_sizes, int n_in, void* d_out, int out_size, void* d_ws, size_t ws_size, hipStream_t stream) {
    static int grid = 0;
    if (grid == 0) {
        if (n_in != 17 || in_sizes[0] != M * D || out_size != M * D || ws_size < WS_END) { fprintf(stderr, "kernel_launch: unexpected shapes (n_in %d, in0 %d, out %d, ws %zu)\n", n_in, n_in > 0 ? in_sizes[0] : -1, out_size, ws_size); grid = -1; return; }
        int dev = 0, cus = 0, per_cu = 0;
        if (hipGetDevice(&dev) != hipSuccess || hipDeviceGetAttribute(&cus, hipDeviceAttributeMultiprocessorCount, dev) != hipSuccess) { grid = -1; return; }
        if (hipFuncSetAttribute((const void*)mk_fwd, hipFuncAttributeMaxDynamicSharedMemorySize, LDS_BYTES) != hipSuccess) { fprintf(stderr, "kernel_launch: hipFuncSetAttribute failed\n"); grid = -1; return; }
        if (hipOccupancyMaxActiveBlocksPerMultiprocessor(&per_cu, (const void*)mk_fwd, NWAVES * 64, LDS_BYTES) != hipSuccess || per_cu < 1)
            fprintf(stderr, "kernel_launch: occupancy query reports %d workgroups per CU\n", per_cu);
        (void)hipGetLastError();
        if (cus != 256) { fprintf(stderr, "kernel_launch: built for a 256-CU device (got %d CUs); nothing launched\n", cus); grid = -1; return; }
        grid = cus;
    }
    if (grid < 0) return;
    if (hipMemsetAsync((char*)d_ws + WS_CTL, 0, CTL_ZERO_BYTES, stream) != hipSuccess) return;
    Args a{};
    for (int i = 0; i < 17; ++i) a.in[i] = (const float*)d_in[i];
    a.out = (float*)d_out; a.ws = (unsigned char*)d_ws;
    if (MK_N_LAUNCHES == 1) {
        a.ph_lo = 0; a.ph_hi = NPHASE; a.li = 0;
        hipLaunchKernelGGL(mk_fwd, dim3(grid), dim3(NWAVES * 64), LDS_BYTES, stream, a);
    } else {
        for (int p = 0; p < MK_PH_END; ++p) { a.ph_lo = p; a.ph_hi = p + 1; a.li = p; hipLaunchKernelGGL(mk_fwd, dim3(grid), dim3(NWAVES * 64), LDS_BYTES, stream, a); }
    }
    const hipError_t le = hipPeekAtLastError();
    if (le != hipSuccess) fprintf(stderr, "kernel_launch: launch failed: %s\n", hipGetErrorName(le));
}
```

```cpp
#include <hip/hip_runtime.h>
#include <cstdio>
#include <cstdint>

#ifndef MK_REPEAT
#define MK_REPEAT 0
#endif
#define REP(k, cond) _Pragma("unroll 1") for (int rep_ = 0; rep_ < 1 + ((((MK_REPEAT) >> (k)) & 1) && (cond) ? 1 : 0); ++rep_)
#ifndef MK_PH_END
#define MK_PH_END 17
#endif
#ifndef MK_PACE7
#define MK_PACE7 2
#endif
#ifndef MK_PACE2
#define MK_PACE2 0
#endif
#ifndef MK_N_LAUNCHES
#define MK_N_LAUNCHES 1
#endif

constexpr int D = 2048, SEQ = 4096, M = 8192, DEPTH = 2;
constexpr int INC = 8704;
constexpr int C_Q = 0, C_K = 1024, C_V = 1280, C_CB = 1536, C_CC = 2560, C_CX = 3584, C_GA = 4608, C_GC = 6656;
constexpr int NE = 32, FF = 512;
constexpr float NORM_EPS = 1e-5f;
constexpr int NPHASE = 1 + 8 * DEPTH;

constexpr size_t MiB = 1u << 20;
constexpr size_t WS_CTL = 0, CTL_ZERO_BYTES = 128 * 1024;
constexpr size_t WS_ROPE = 1 * MiB;
constexpr size_t WS_TOK = 2 * MiB;
constexpr size_t WS_WGT = 3 * MiB;
constexpr size_t WS_WL = 4 * MiB, WL_STRIDE = 243 * MiB;
constexpr size_t WL_IN = 0, WL_A = 34 * MiB, WL_C = 38 * MiB, WL_O = 42 * MiB, WL_GU = 50 * MiB, WL_D = 178 * MiB, WL_R = 242 * MiB;
constexpr int N_BF = 4608, N_F8 = 4096;
constexpr size_t WL_IN8 = WL_IN + (size_t)N_BF * 2048 * 2;
constexpr float W8_SCALE = 64.f;
constexpr size_t WR_LO_OFF = 48 * 2048 * 2;
constexpr size_t WS_XRES = 490 * MiB;
constexpr size_t WS_H = 554 * MiB;
constexpr size_t WS_P = 586 * MiB;
constexpr size_t WS_Y2 = WS_P;
constexpr size_t WS_AO = 722 * MiB, WS_CV = 738 * MiB;
constexpr size_t WS_PART = 754 * MiB;
constexpr size_t WS_H8 = 760 * MiB;
constexpr size_t WS_PARTL = 778 * MiB;
constexpr size_t WS_RSL = 756 * MiB;
constexpr size_t WS_MG = 818 * MiB;
constexpr size_t WS_ACT = 850 * MiB;
constexpr size_t WS_END = 874 * MiB;
constexpr int CW_TMO = 0, CW_CODE = 1, CW_BAR = 4096, CW_CNT = 16384;

constexpr int RING_BYTES = 131072;
constexpr int LDSCTL_OFF = RING_BYTES;
constexpr int MISC_OFF = LDSCTL_OFF + 320;
constexpr int TILE_OFF = LDSCTL_OFF + 1024;
constexpr int GTAB_OFF = LDSCTL_OFF + 4096;
constexpr int RTAB_OFF = LDSCTL_OFF + 12288;
constexpr int LTAB_OFF = LDSCTL_OFF + 8192;
constexpr int RB = 4;
constexpr int GU_SPLIT2 = 32768 - 3584;
constexpr int NSHARD = 8, SHARD_CAP = 1024;
constexpr int LDS_BYTES = 147456;
constexpr int NWAVES = 8;

#define GAS __attribute__((address_space(1)))
#define LAS __attribute__((address_space(3)))
typedef unsigned short bf16;
typedef unsigned v4u __attribute__((ext_vector_type(4)));
typedef unsigned v2u __attribute__((ext_vector_type(2)));
typedef float f32x4 __attribute__((ext_vector_type(4)));
typedef float f32x16 __attribute__((ext_vector_type(16)));
typedef short bf16x8 __attribute__((ext_vector_type(8)));
typedef short s16x4 __attribute__((ext_vector_type(4)));
typedef GAS unsigned gu32;
#define RLX_AGENT __ATOMIC_RELAXED, __HIP_MEMORY_SCOPE_AGENT
#define LDS_WAIT() asm volatile("s_waitcnt lgkmcnt(0)" ::: "memory")
#define VM_WAIT() asm volatile("s_waitcnt vmcnt(0)" ::: "memory")

__device__ __forceinline__ unsigned f2bf(float f) { unsigned u = __builtin_bit_cast(unsigned, f); return (u + 0x7fffu + ((u >> 16) & 1u)) >> 16; }
__device__ __forceinline__ unsigned pk2i(float lo, float hi) { return f2bf(lo) | (f2bf(hi) << 16); }
typedef float f32x2_t __attribute__((ext_vector_type(2))); typedef __bf16 bf16x2_t __attribute__((ext_vector_type(2)));
__device__ __forceinline__ unsigned pk2(float lo, float hi) { const f32x2_t v = {lo, hi}; const bf16x2_t b = __builtin_convertvector(v, bf16x2_t); return __builtin_bit_cast(unsigned, b); }
__device__ __forceinline__ float bflo(unsigned w) { return __builtin_bit_cast(float, w << 16); }
__device__ __forceinline__ float bfhi(unsigned w) { return __builtin_bit_cast(float, w & 0xffff0000u); }
__device__ __forceinline__ unsigned pk4_fp8(float a, float b, float c, float d) { int w = 0; w = __builtin_amdgcn_cvt_pk_fp8_f32(a, b, w, false); w = __builtin_amdgcn_cvt_pk_fp8_f32(c, d, w, true); return (unsigned)w; }
__device__ __forceinline__ float sigmoidf_(float v) { return __builtin_amdgcn_rcpf(1.0f + __expf(-v)); }
__device__ __forceinline__ unsigned gate_u8x4(f32x4 g) { return (unsigned)(g.x * 255.f + 0.5f) | ((unsigned)(g.y * 255.f + 0.5f) << 8) | ((unsigned)(g.z * 255.f + 0.5f) << 16) | ((unsigned)(g.w * 255.f + 0.5f) << 24); }
__device__ __forceinline__ float gate_f(unsigned w, int k) { return (float)((w >> (8 * k)) & 255u) * (1.0f / 255.f); }

namespace pg8 {
#define PG8_LAS __attribute__((address_space(3)))
typedef unsigned short bf16_t;
constexpr int BM = 256, BK = 64, HALF = 128, HTB = HALF * BK * 2, STAGE_BYTES = 8 * HTB, NXCD = 8, WGM = 8;

__host__ __device__ __forceinline__ int lds_byte(int r, int c) { const int st = (r >> 4) * 2 + (c >> 5), rr = r & 15, cc = c & 31, ob = rr * 64 + cc * 2; return st * 1024 + (ob ^ (((ob >> 9) & 1) << 5)); }
__host__ __device__ __forceinline__ void stage_rc(int b, int& R, int& C) { const int st = b / 1024, sb = b % 1024, swz = sb ^ (((sb >> 9) & 1) << 5); R = (st >> 1) * 16 + swz / 64; C = (st & 1) * 32 + (swz % 64) / 2; }
__host__ __device__ __forceinline__ int perm32(int rho) { const int n = rho >> 4, i = rho & 15; return 8 * (i >> 2) + 4 * n + (i & 3); }

struct Unit { int pm, pn, aux; };
typedef int v8i_t __attribute__((ext_vector_type(8)));

struct TileOrder {
    int nM, nN, nwg, G, c;
    __device__ void init(int Mr, int Nc, int G_, int c_) { nM = Mr / BM; nN = Nc / BM; nwg = nM * nN; G = G_; c = c_; }
    __device__ bool tile(int i, int& pm, int& pn) const {
        const long L = (long)i * G + c; if (L >= nwg) return false;
        int wgid = (int)L; { const int q = nwg / NXCD, r = nwg % NXCD, xcd = wgid % NXCD, off = wgid / NXCD; wgid = (xcd < r ? xcd * (q + 1) : r * (q + 1) + (xcd - r) * q) + off; }
        const int nig = WGM * nN, gid = wgid / nig, fm = gid * WGM, gsz = (nM - fm) < WGM ? (nM - fm) : WGM;
        pm = fm + ((wgid % nig) % gsz); pn = (wgid % nig) / gsz; return true;
    }
};

template <class Epi, class Sched, bool ALIGN_EPI, bool GATHER, bool F8 = false>
__device__ __forceinline__ void gemm_phase(PG8_LAS unsigned char* lds, const int K, const Sched& S, const Epi& E) {
    int tid_ = threadIdx.x; asm volatile("" : "+v"(tid_));
    const int tid = tid_, wid = __builtin_amdgcn_readfirstlane(tid >> 6), lane = tid & 63, wr = wid >> 2, wc = wid & 3, fr = lane & 15, fq = lane >> 4;
    const int nt = K / BK;
    unsigned voffA[2], voffB[2]; int RA[2]; unsigned CA[2];
#pragma unroll
    for (int i = 0; i < 2; ++i) { int R, C; stage_rc(tid * 16 + i * 8192, R, C); const int Rb = Epi::PERM ? ((R & ~31) + perm32(R & 31)) : R;
        voffA[i] = (unsigned)(R * K + C) * 2u; voffB[i] = (unsigned)(Rb * K + C) * 2u; RA[i] = R; CA[i] = (unsigned)C * 2u; }
    const size_t kstep = (size_t)(BK * 2);
    const size_t hstep = (size_t)HALF * K * 2;
    const unsigned ldsw = (unsigned)wid * 1024u;
    const int aoff = lds_byte(wr * 64 + fr, fq * 8), boff = lds_byte(wc * 32 + fr, fq * 8);
    unsigned gvo[2][2], ngvo[2][2];
#define PG8_SA(b, h) (((b) * 2 + (h)) * HTB)
#define PG8_SB(b, h) ((4 + (b) * 2 + (h)) * HTB)
#define PG8_STAGE2(bufoff, gbase, v0, v1) do { \
        __builtin_amdgcn_global_load_lds((const unsigned*)((const char*)(gbase) + (v0)), (PG8_LAS unsigned*)(lds + (bufoff) + ldsw), 16, 0, 0); \
        __builtin_amdgcn_global_load_lds((const unsigned*)((const char*)(gbase) + (v1)), (PG8_LAS unsigned*)(lds + (bufoff) + ldsw + 8192), 16, 0, 0); } while (0)
#define PG8_STAGE_B(bufoff, gbase) PG8_STAGE2(bufoff, gbase, voffB[0], voffB[1])
#define PG8_STAGE_A(bufoff, kbase, h, nx) do { if constexpr (GATHER) { const unsigned _v0 = (nx) ? ngvo[h][0] : gvo[h][0], _v1 = (nx) ? ngvo[h][1] : gvo[h][1]; PG8_STAGE2(bufoff, kbase, _v0, _v1); } \
        else { PG8_STAGE2(bufoff, (kbase) + (h) * hstep, voffA[0], voffA[1]); } } while (0)
#define PG8_CAT(p) __builtin_bit_cast(v8i_t, __builtin_shufflevector(*(const PG8_LAS bf16x8*)(p), *(const PG8_LAS bf16x8*)((p) + 1024), 0, 1, 2, 3, 4, 5, 6, 7, 8, 9, 10, 11, 12, 13, 14, 15))
#define PG8_LDA8(b, h) do { _Pragma("unroll") for (int m = 0; m < 4; ++m) At8[m] = PG8_CAT(lds + PG8_SA(b, h) + aoff + m * 2048); } while (0)
#define PG8_LDB8(dst, b, h) do { _Pragma("unroll") for (int n = 0; n < 2; ++n) dst[n] = PG8_CAT(lds + PG8_SB(b, h) + boff + n * 2048); } while (0)
#define PG8_MMA8(ai, bj, Bt8) do { __builtin_amdgcn_s_setprio(1); _Pragma("unroll") for (int m = 0; m < 4; ++m) _Pragma("unroll") for (int n = 0; n < 2; ++n) \
        asm volatile("v_mfma_f32_16x16x128_f8f6f4 %0, %1, %2, %0" : "+v"(acc[ai][bj][m][n]) : "v"(Bt8[n]), "v"(At8[m])); __builtin_amdgcn_s_setprio(0); } while (0)
#define PG8_LDA(dst, b, h) do { _Pragma("unroll") for (int m = 0; m < 4; ++m) _Pragma("unroll") for (int k = 0; k < 2; ++k) dst[m][k] = *(const PG8_LAS bf16x8*)(lds + PG8_SA(b, h) + aoff + m * 2048 + k * 1024); } while (0)
#define PG8_LDB(dst, b, h) do { _Pragma("unroll") for (int n = 0; n < 2; ++n) _Pragma("unroll") for (int k = 0; k < 2; ++k) dst[n][k] = *(const PG8_LAS bf16x8*)(lds + PG8_SB(b, h) + boff + n * 2048 + k * 1024); } while (0)
#define PG8_MMA(ai, bj, At, Bt) do { __builtin_amdgcn_s_setprio(1); if constexpr (F8) { _Pragma("unroll") for (int m = 0; m < 4; ++m) _Pragma("unroll") for (int n = 0; n < 2; ++n) \
        acc[ai][bj][m][n] = __builtin_amdgcn_mfma_scale_f32_16x16x128_f8f6f4(__builtin_bit_cast(v8i_t, __builtin_shufflevector(Bt[n][0], Bt[n][1], 0, 1, 2, 3, 4, 5, 6, 7, 8, 9, 10, 11, 12, 13, 14, 15)), \
            __builtin_bit_cast(v8i_t, __builtin_shufflevector(At[m][0], At[m][1], 0, 1, 2, 3, 4, 5, 6, 7, 8, 9, 10, 11, 12, 13, 14, 15)), acc[ai][bj][m][n], 0, 0, 0, 0, 0, 0); } \
        else { _Pragma("unroll") for (int m = 0; m < 4; ++m) _Pragma("unroll") for (int n = 0; n < 2; ++n) _Pragma("unroll") for (int k = 0; k < 2; ++k) \
        acc[ai][bj][m][n] = __builtin_amdgcn_mfma_f32_16x16x32_bf16(Bt[n][k], At[m][k], acc[ai][bj][m][n], 0, 0, 0); } __builtin_amdgcn_s_setprio(0); } while (0)
#define PG8_WAIT_V(n) asm volatile("s_waitcnt vmcnt(" #n ")" ::: "memory")
#define PG8_WAIT_L(n) asm volatile("s_waitcnt lgkmcnt(" #n ")" ::: "memory")
#define PG8_BAR __builtin_amdgcn_s_barrier()
#define PG8_SCHED __builtin_amdgcn_sched_barrier(0)
    Unit cur, nxt; int ui = 0;
    if (!S.next(0, cur)) return;
    f32x4 acc[2][2][4][2];
    E.init(acc, cur, wr, wc, fr, fq);
    bf16x8 At[4][2], B0[2][2], B1[2][2];
    v8i_t At8[4], B08[2], B18[2]; (void)At8; (void)B08; (void)B18;
    const char* cA = S.abase(cur); const char* cB = S.bbase(cur);
    if constexpr (GATHER) {
#pragma unroll
        for (int h = 0; h < 2; ++h)
#pragma unroll
            for (int i = 0; i < 2; ++i) { gvo[h][i] = S.goff(0, h * HALF + RA[i]) + CA[i]; ngvo[h][i] = gvo[h][i]; }
    }
    PG8_STAGE_B(PG8_SB(0, 0), cB); PG8_STAGE_B(PG8_SB(0, 1), cB + hstep); PG8_STAGE_A(PG8_SA(0, 0), cA, 0, false); PG8_STAGE_A(PG8_SA(0, 1), cA, 1, false);
    if (wr == 1) PG8_BAR;
    PG8_WAIT_V(2); PG8_BAR;
    PG8_STAGE_B(PG8_SB(1, 0), cB + kstep); PG8_STAGE_A(PG8_SA(1, 0), cA + kstep, 0, false); PG8_STAGE_B(PG8_SB(1, 1), cB + hstep + kstep);
    PG8_WAIT_V(6); PG8_BAR;
    for (;;) {
        const bool has_next = S.next(ui + 1, nxt);
        const char* nA = has_next ? S.abase(nxt) : cA; const char* nB = has_next ? S.bbase(nxt) : cB;
        if constexpr (GATHER) {
            if (has_next) {
#pragma unroll
                for (int h = 0; h < 2; ++h)
#pragma unroll
                    for (int i = 0; i < 2; ++i) ngvo[h][i] = S.goff(ui + 1, h * HALF + RA[i]) + CA[i];
            }
        }
        for (int t = 0; t < nt; t += 2) {
            const bool last = (t == nt - 2);
            const char* a1 = cA + (size_t)(t + 1) * kstep;
            const char* a2 = last ? nA : cA + (size_t)(t + 2) * kstep; const char* b2 = last ? nB : cB + (size_t)(t + 2) * kstep;
            const char* a3 = a2 + kstep; const char* b3 = b2 + kstep;
            if constexpr (F8) {
            PG8_LDB8(B08, 0, 0); PG8_LDB8(B18, 0, 1); PG8_SCHED; PG8_LDA8(0, 0); PG8_STAGE_A(PG8_SA(1, 1), a1, 1, false);
            PG8_WAIT_V(8); PG8_WAIT_L(0); PG8_BAR; PG8_MMA8(0, 0, B08); PG8_MMA8(0, 1, B18); PG8_BAR; PG8_SCHED;
            PG8_LDA8(0, 1); PG8_STAGE_B(PG8_SB(0, 0), b2); PG8_STAGE_B(PG8_SB(0, 1), b2 + hstep); PG8_STAGE_A(PG8_SA(0, 0), a2, 0, last);
            PG8_WAIT_V(8); PG8_WAIT_L(0); PG8_BAR; PG8_MMA8(1, 0, B08); PG8_MMA8(1, 1, B18); PG8_BAR; PG8_SCHED;
            PG8_LDB8(B08, 1, 0); PG8_LDB8(B18, 1, 1); PG8_SCHED; PG8_LDA8(1, 0); PG8_STAGE_A(PG8_SA(0, 1), a2, 1, last);
            PG8_WAIT_V(8); PG8_WAIT_L(0); PG8_BAR; PG8_MMA8(0, 0, B08); PG8_MMA8(0, 1, B18); PG8_BAR; PG8_SCHED;
            PG8_LDA8(1, 1); PG8_STAGE_B(PG8_SB(1, 0), b3); PG8_STAGE_B(PG8_SB(1, 1), b3 + hstep); PG8_STAGE_A(PG8_SA(1, 0), a3, 0, last);
            PG8_WAIT_V(8); PG8_WAIT_L(0); PG8_BAR; PG8_MMA8(1, 0, B08); PG8_MMA8(1, 1, B18); PG8_BAR; PG8_SCHED;
            } else {
            PG8_LDB(B0, 0, 0); PG8_LDB(B1, 0, 1); PG8_SCHED; PG8_LDA(At, 0, 0); PG8_STAGE_A(PG8_SA(1, 1), a1, 1, false);
            PG8_WAIT_V(8); PG8_WAIT_L(0); PG8_BAR; PG8_MMA(0, 0, At, B0); PG8_MMA(0, 1, At, B1); PG8_BAR; PG8_SCHED;
            PG8_LDA(At, 0, 1); PG8_STAGE_B(PG8_SB(0, 0), b2); PG8_STAGE_B(PG8_SB(0, 1), b2 + hstep); PG8_STAGE_A(PG8_SA(0, 0), a2, 0, last);
            PG8_WAIT_V(8); PG8_WAIT_L(0); PG8_BAR; PG8_MMA(1, 0, At, B0); PG8_MMA(1, 1, At, B1); PG8_BAR; PG8_SCHED;
            PG8_LDB(B0, 1, 0); PG8_LDB(B1, 1, 1); PG8_SCHED; PG8_LDA(At, 1, 0); PG8_STAGE_A(PG8_SA(0, 1), a2, 1, last);
            PG8_WAIT_V(8); PG8_WAIT_L(0); PG8_BAR; PG8_MMA(0, 0, At, B0); PG8_MMA(0, 1, At, B1); PG8_BAR; PG8_SCHED;
            PG8_LDA(At, 1, 1); PG8_STAGE_B(PG8_SB(1, 0), b3); PG8_STAGE_B(PG8_SB(1, 1), b3 + hstep); PG8_STAGE_A(PG8_SA(1, 0), a3, 0, last);
            PG8_WAIT_V(8); PG8_WAIT_L(0); PG8_BAR; PG8_MMA(1, 0, At, B0); PG8_MMA(1, 1, At, B1); PG8_BAR; PG8_SCHED;
            }
        }
        if constexpr (F8) asm volatile("s_nop 15\n\ts_nop 15" ::: "memory");
        if constexpr (ALIGN_EPI) { if (wr == 0) PG8_BAR; }
        if constexpr (!Epi::AFTER_DRAIN) E(acc, cur, wr, wc, fr, fq);
        if (!has_next) break;
        if (!E.keep_acc(cur)) E.init(acc, nxt, wr, wc, fr, fq);
        cur = nxt; cA = nA; cB = nB; ++ui;
        if constexpr (GATHER) {
#pragma unroll
            for (int h = 0; h < 2; ++h)
#pragma unroll
                for (int i = 0; i < 2; ++i) gvo[h][i] = ngvo[h][i];
        }
        if constexpr (ALIGN_EPI) { if (wr == 1) PG8_BAR; }
    }
    PG8_WAIT_V(0);
    if constexpr (!ALIGN_EPI) { if (wr == 0) PG8_BAR; }
    PG8_BAR;
    if constexpr (Epi::AFTER_DRAIN) E.fused(acc, cur, wr, wc, fr, fq, lds, tid);
#undef PG8_SA
#undef PG8_SB
#undef PG8_STAGE2
#undef PG8_STAGE_A
#undef PG8_STAGE_B
#undef PG8_LDA
#undef PG8_CAT
#undef PG8_LDA8
#undef PG8_LDB8
#undef PG8_MMA8
#undef PG8_LDB
#undef PG8_MMA
#undef PG8_WAIT_V
#undef PG8_WAIT_L
#undef PG8_BAR
#undef PG8_SCHED
}
}

struct SchedPlain {
    pg8::TileOrder T; const char* A; const char* Bt; size_t tstep;
    __device__ __forceinline__ bool next(int i, pg8::Unit& u) const { u.aux = 0; return T.tile(i, u.pm, u.pn); }
    __device__ __forceinline__ const char* abase(const pg8::Unit& u) const { return A + (size_t)u.pm * tstep; }
    __device__ __forceinline__ const char* bbase(const pg8::Unit& u) const { return Bt + (size_t)u.pn * tstep; }
    __device__ __forceinline__ unsigned goff(int, int) const { return 0u; }
};
struct SchedPair {
    pg8::TileOrder T; const char* A0; const char* A1; const char* B0; const char* B1; size_t tstep;
    __device__ __forceinline__ bool next(int i, pg8::Unit& u) const { u.aux = i & 1; return T.tile(i >> 1, u.pm, u.pn); }
    __device__ __forceinline__ const char* abase(const pg8::Unit& u) const { return (u.aux ? A1 : A0) + (size_t)u.pm * tstep; }
    __device__ __forceinline__ const char* bbase(const pg8::Unit& u) const { return (u.aux ? B1 : B0) + (size_t)u.pn * tstep; }
    __device__ __forceinline__ unsigned goff(int, int) const { return 0u; }
};
struct SchedMoe {
    const LAS int* tile_e; const LAS int* tile_mt; const LAS unsigned* gtab; int ntiles, nN, G, c;
    const char* A; const char* Bt; size_t a_tstep, b_estep, b_tstep; bool gather;
    __device__ __forceinline__ bool next(int i, pg8::Unit& u) const {
        int tile, pn;
        if (nN == 4) { const int x = c & 7, j = c >> 3, tp = (ntiles + 7) >> 3, t = i * (G >> 3) + j; if (t >= 4 * tp) return false; tile = x * tp + (t >> 2); if (tile >= ntiles) return false; pn = t & 3; }
        else { const int L = i * G + c; if (L >= ntiles * nN) return false; tile = L / nN; pn = L - tile * nN; }
        u.pm = tile; u.pn = pn; u.aux = tile_e[tile] | (tile_mt[tile] << 8) | (i << 16); return true; }
    __device__ __forceinline__ const char* abase(const pg8::Unit& u) const { return gather ? A : A + (size_t)u.pm * a_tstep; }
    __device__ __forceinline__ const char* bbase(const pg8::Unit& u) const { return Bt + (size_t)(u.aux & 255) * b_estep + (size_t)u.pn * b_tstep; }
    __device__ __forceinline__ unsigned goff(int ui, int row) const { return gtab[ui * 256 + row]; }
};

using pg8::Unit;
struct EpiInProj {
    static constexpr bool PERM = true; static constexpr bool AFTER_DRAIN = false;
    bf16* P; const float* rope; int pn_off; float pre;
    __device__ __forceinline__ bool keep_acc(const Unit&) const { return false; }
    __device__ __forceinline__ void init(f32x4 (&acc)[2][2][4][2], const Unit&, int, int, int, int) const {
#pragma unroll
        for (int a = 0; a < 2; ++a)
#pragma unroll
            for (int b = 0; b < 2; ++b)
#pragma unroll
                for (int m = 0; m < 4; ++m)
#pragma unroll
                    for (int n = 0; n < 2; ++n) acc[a][b][m][n] = (f32x4){0.f, 0.f, 0.f, 0.f};
    }
    __device__ __forceinline__ void operator()(f32x4 (&acc)[2][2][4][2], const Unit& u, int wr, int wc, int fr_in, int fq_in) const {
        int fr = fr_in, fq = fq_in; asm volatile("" : "+v"(fr), "+v"(fq));
        const int pn = u.pn + pn_off;
        const int row0 = u.pm * 256 + wr * 64 + fr, col0 = pn * 256 + wc * 32 + 8 * fq;
        const int kind = pn <= 3 ? 0 : (pn == 4 ? 1 : (pn < 18 ? 2 : 3));
        const bool do_rope = (kind <= 1) && ((wc & 1) == 0);
        const float sgn = fq == 0 ? -1.f : 1.f;
#pragma unroll
        for (int ai = 0; ai < 2; ++ai)
#pragma unroll
            for (int m = 0; m < 4; ++m) {
                const int row = row0 + ai * 128 + m * 16;
                bf16* rowp = P + (size_t)row * INC + col0;
                f32x4 c0 = {1.f, 1.f, 1.f, 1.f}, c1 = c0, s0 = {0.f, 0.f, 0.f, 0.f}, s1 = s0;
                if (do_rope) { const f32x4* rp = (const f32x4*)(rope + (size_t)(row & (SEQ - 1)) * 16); c0 = rp[0]; c1 = rp[1]; s0 = rp[2]; s1 = rp[3]; }
#pragma unroll
                for (int bj = 0; bj < 2; ++bj) {
                    f32x4 v0 = acc[ai][bj][m][0], v1 = acc[ai][bj][m][1];
                    if (do_rope) {
                        f32x4 p0, p1;
#pragma unroll
                        for (int e = 0; e < 4; ++e) { p0[e] = __shfl_xor(v0[e], 16); p1[e] = __shfl_xor(v1[e], 16); }
                        if (fq < 2) { v0 = v0 * c0 + p0 * s0 * sgn; v1 = v1 * c1 + p1 * s1 * sgn; }
                    }
                    if (kind == 0) { v0 = v0 * 0.125f; v1 = v1 * 0.125f; }
                    if (kind == 3) {
#pragma unroll
                        for (int e = 0; e < 4; ++e) { v0[e] = sigmoidf_(v0[e] * pre); v1[e] = sigmoidf_(v1[e] * pre); }
                    }
                    if (kind == 3) {
                        v2u q; q.x = gate_u8x4(v0); q.y = gate_u8x4(v1);
                        *(v2u*)((unsigned char*)(P + (size_t)row * INC + C_GA) + (col0 - C_GA) + bj * 128) = q;
                    } else {
                    v4u w; w.x = pk2(v0[0], v0[1]); w.y = pk2(v0[2], v0[3]); w.z = pk2(v1[0], v1[1]); w.w = pk2(v1[2], v1[3]);
                    *(v4u*)(rowp + bj * 128) = w;
                    }
                }
            }
    }
};
struct EpiMerge {
    static constexpr bool PERM = true; static constexpr bool AFTER_DRAIN = false;
    const bf16* P; bf16* MG;
    __device__ __forceinline__ bool keep_acc(const Unit& u) const { return u.aux == 0; }
    __device__ __forceinline__ void init(f32x4 (&acc)[2][2][4][2], const Unit&, int, int, int, int) const {
#pragma unroll
        for (int a = 0; a < 2; ++a)
#pragma unroll
            for (int b = 0; b < 2; ++b)
#pragma unroll
                for (int m = 0; m < 4; ++m)
#pragma unroll
                    for (int n = 0; n < 2; ++n) acc[a][b][m][n] = (f32x4){0.f, 0.f, 0.f, 0.f};
    }
    __device__ __forceinline__ void operator()(f32x4 (&acc)[2][2][4][2], const Unit& u, int wr, int wc, int fr_in, int fq_in) const {
        int fr = fr_in, fq = fq_in; asm volatile("" : "+v"(fr), "+v"(fq));
        const int row0 = u.pm * 256 + wr * 64 + fr, col0 = u.pn * 256 + wc * 32 + 8 * fq;
        const unsigned char* gp0 = (const unsigned char*)(P + (size_t)row0 * INC + C_GA) + col0;
        constexpr size_t RB = (size_t)INC * 2;
        if (u.aux == 0) {
            v2u gc[2][2][2], ga[2][2][2];
#pragma unroll
            for (int r = 0; r < 2; ++r)
#pragma unroll
                for (int bj = 0; bj < 2; ++bj) { const unsigned char* gp = gp0 + (size_t)(r * 16) * RB + bj * 128; gc[0][r][bj] = *(const v2u*)(gp + 2048); ga[0][r][bj] = *(const v2u*)gp; }
#pragma unroll
            for (int h = 0; h < 4; ++h) {
                if (h < 3) {
#pragma unroll
                    for (int r = 0; r < 2; ++r)
#pragma unroll
                        for (int bj = 0; bj < 2; ++bj) { const unsigned char* gp = gp0 + (size_t)(((h + 1) >> 1) * 128 + (2 * ((h + 1) & 1) + r) * 16) * RB + bj * 128; gc[(h + 1) & 1][r][bj] = *(const v2u*)(gp + 2048); ga[(h + 1) & 1][r][bj] = *(const v2u*)gp; }
                }
#pragma unroll
                for (int r = 0; r < 2; ++r)
#pragma unroll
                    for (int bj = 0; bj < 2; ++bj) {
                        const v2u c = gc[h & 1][r][bj], a = ga[h & 1][r][bj];
                        f32x4& v0 = acc[h >> 1][bj][2 * (h & 1) + r][0]; f32x4& v1 = acc[h >> 1][bj][2 * (h & 1) + r][1];
#pragma unroll
                        for (int e = 0; e < 4; ++e) { v0[e] *= gate_f(a.x, e) * __builtin_amdgcn_rcpf(__builtin_fmaxf(gate_f(c.x, e), 1e-30f)); v1[e] *= gate_f(a.y, e) * __builtin_amdgcn_rcpf(__builtin_fmaxf(gate_f(c.y, e), 1e-30f)); }
                    }
            }
        } else {
            v2u gc[2][2][2];
#pragma unroll
            for (int r = 0; r < 2; ++r)
#pragma unroll
                for (int bj = 0; bj < 2; ++bj) gc[0][r][bj] = *(const v2u*)(gp0 + (size_t)(r * 16) * RB + bj * 128 + 2048);
#pragma unroll
            for (int h = 0; h < 4; ++h) {
                if (h < 3) {
#pragma unroll
                    for (int r = 0; r < 2; ++r)
#pragma unroll
                        for (int bj = 0; bj < 2; ++bj) gc[(h + 1) & 1][r][bj] = *(const v2u*)(gp0 + (size_t)(((h + 1) >> 1) * 128 + (2 * ((h + 1) & 1) + r) * 16) * RB + bj * 128 + 2048);
                }
#pragma unroll
                for (int r = 0; r < 2; ++r)
#pragma unroll
                    for (int bj = 0; bj < 2; ++bj) {
                        const v2u c = gc[h & 1][r][bj];
                        const int mm = 2 * (h & 1) + r;
                        f32x4 v0 = acc[h >> 1][bj][mm][0], v1 = acc[h >> 1][bj][mm][1];
#pragma unroll
                        for (int e = 0; e < 4; ++e) { v0[e] *= __builtin_fmaxf(gate_f(c.x, e), 1e-30f); v1[e] *= __builtin_fmaxf(gate_f(c.y, e), 1e-30f); }
                        v4u w; w.x = pk2(v0[0], v0[1]); w.y = pk2(v0[2], v0[3]); w.z = pk2(v1[0], v1[1]); w.w = pk2(v1[2], v1[3]);
                        *(v4u*)(MG + (size_t)(row0 + (h >> 1) * 128 + mm * 16) * D + col0 + bj * 128) = w;
                    }
            }
        }
    }
};
struct EpiResHx {
    static constexpr bool PERM = true; static constexpr int B_AUX = 0; static constexpr bool AFTER_DRAIN = true;
    const float* base; bf16* out; bf16* HX; const float* g; float* part; const bf16* Wr; float* partl; const bf16* baseh;
    __device__ __forceinline__ bool keep_acc(const Unit&) const { return false; }
    __device__ __forceinline__ void init(f32x4 (&acc)[2][2][4][2], const Unit& u, int wr, int wc, int fr, int fq) const {
        const int row0 = u.pm * 256 + wr * 64 + fr, col0 = u.pn * 256 + wc * 32 + 8 * fq;
#pragma unroll
        for (int ai = 0; ai < 2; ++ai)
#pragma unroll
            for (int m = 0; m < 4; ++m) { const size_t off = (size_t)(row0 + ai * 128 + m * 16) * D + col0;
                if (baseh) {
#pragma unroll
                    for (int bj = 0; bj < 2; ++bj) { const v4u w = *(const v4u*)(baseh + off + bj * 128);
                        acc[ai][bj][m][0] = (f32x4){bflo(w.x), bfhi(w.x), bflo(w.y), bfhi(w.y)}; acc[ai][bj][m][1] = (f32x4){bflo(w.z), bfhi(w.z), bflo(w.w), bfhi(w.w)}; }
                } else {
#pragma unroll
                for (int bj = 0; bj < 2; ++bj) { acc[ai][bj][m][0] = *(const f32x4*)(base + off + bj * 128); acc[ai][bj][m][1] = *(const f32x4*)(base + off + bj * 128 + 4); } } }
    }
    __device__ __forceinline__ void fused(f32x4 (&acc)[2][2][4][2], const Unit& u, int wr, int wc, int fr, int fq, LAS unsigned char* lds, int tid) const {
        const int row0 = u.pm * 256 + wr * 64 + fr, col0 = u.pn * 256 + wc * 32 + 8 * fq;
        f32x4 gv[2][2]; bf16x8 Wf[2][3];
#pragma unroll
        for (int bj = 0; bj < 2; ++bj) { gv[bj][0] = *(const f32x4*)(g + col0 + bj * 128); gv[bj][1] = *(const f32x4*)(g + col0 + bj * 128 + 4);
#pragma unroll
            for (int cb = 0; cb < 3; ++cb) Wf[bj][cb] = *(const bf16x8*)(Wr + (size_t)(16 * cb + fr) * D + col0 + bj * 128); }
        LAS float* red = (LAS float*)lds;
#pragma unroll
        for (int ai = 0; ai < 2; ++ai) {
#pragma unroll
            for (int m = 0; m < 4; ++m) {
                const int row = row0 + ai * 128 + m * 16; const size_t off = (size_t)row * D + col0;
                float ssum = 0.f; f32x4 la[3] = {{0.f, 0.f, 0.f, 0.f}, {0.f, 0.f, 0.f, 0.f}, {0.f, 0.f, 0.f, 0.f}};
#pragma unroll
                for (int bj = 0; bj < 2; ++bj) {
                    const f32x4 v0 = acc[ai][bj][m][0], v1 = acc[ai][bj][m][1];
                    { v4u xw; xw.x = pk2(v0.x, v0.y); xw.y = pk2(v0.z, v0.w); xw.z = pk2(v1.x, v1.y); xw.w = pk2(v1.z, v1.w); *(v4u*)(out + off + bj * 128) = xw; }
                    ssum += (v0.x * v0.x + v0.y * v0.y) + (v0.z * v0.z + v0.w * v0.w) + (v1.x * v1.x + v1.y * v1.y) + (v1.z * v1.z + v1.w * v1.w);
                    const f32x4 h0 = v0 * gv[bj][0], h1 = v1 * gv[bj][1];
                    v4u w; w.x = pk2(h0.x, h0.y); w.y = pk2(h0.z, h0.w); w.z = pk2(h1.x, h1.y); w.w = pk2(h1.z, h1.w);
                    const bf16x8 xf = __builtin_bit_cast(bf16x8, w);
#pragma unroll
                    for (int cb = 0; cb < 3; ++cb) la[cb] = __builtin_amdgcn_mfma_f32_16x16x32_bf16(Wf[bj][cb], xf, la[cb], 0, 0, 0);
                }
                ssum += __shfl_xor(ssum, 16); ssum += __shfl_xor(ssum, 32);
                if (fq == 0) part[(size_t)row * 32 + u.pn * 4 + wc] = ssum;
#pragma unroll
                for (int cb = 0; cb < 3; ++cb) *(LAS f32x4*)(red + (size_t)((wc * 128 + wr * 64 + m * 16 + fr) * 48 + 16 * cb + 4 * fq)) = la[cb];
            }
            __syncthreads();
            for (int idx = tid; idx < 128 * 48; idx += 512) {
                const float t = (red[idx] + red[128 * 48 + idx]) + (red[2 * 128 * 48 + idx] + red[3 * 128 * 48 + idx]);
                const int r = idx / 48, n = idx - r * 48;
                partl[((size_t)(u.pm * 256 + ai * 128 + r) * 8 + u.pn) * 48 + n] = t;
            }
            __syncthreads();
        }
    }
};
struct EpiMoeGU {
    static constexpr bool PERM = true; static constexpr bool AFTER_DRAIN = false;
    bf16* ACT; const LAS float* wtab; const LAS float* rtab;
    __device__ __forceinline__ bool keep_acc(const Unit&) const { return false; }
    __device__ __forceinline__ void init(f32x4 (&acc)[2][2][4][2], const Unit&, int, int, int, int) const {
#pragma unroll
        for (int a = 0; a < 2; ++a)
#pragma unroll
            for (int b = 0; b < 2; ++b)
#pragma unroll
                for (int m = 0; m < 4; ++m)
#pragma unroll
                    for (int n = 0; n < 2; ++n) acc[a][b][m][n] = (f32x4){0.f, 0.f, 0.f, 0.f};
    }
    __device__ __forceinline__ void operator()(f32x4 (&acc)[2][2][4][2], const Unit& u, int wr, int wc, int fr, int fq) const {
        const LAS float* wt = wtab + (u.aux >> 16) * 256; const LAS float* rt = rtab + (u.aux >> 16) * 256;
        const int f0 = u.pn * 128 + wc * 32 + 8 * fq;
        float wrow[2][4], rrow[2][4];
#pragma unroll
        for (int ai = 0; ai < 2; ++ai)
#pragma unroll
            for (int m = 0; m < 4; ++m) { const int rl_ = ai * 128 + wr * 64 + m * 16 + fr; wrow[ai][m] = wt[rl_]; rrow[ai][m] = rt[rl_]; }
#pragma unroll
        for (int ai = 0; ai < 2; ++ai)
#pragma unroll
            for (int m = 0; m < 4; ++m) {
                const int rl = ai * 128 + wr * 64 + m * 16 + fr;
                const float w = wrow[ai][m], rsd = rrow[ai][m];
                const f32x4 g0 = acc[ai][0][m][0] * rsd, g1 = acc[ai][0][m][1] * rsd, u0 = acc[ai][1][m][0], u1 = acc[ai][1][m][1];
                f32x4 a0, a1;
#pragma unroll
                for (int k = 0; k < 4; ++k) { a0[k] = g0[k] * sigmoidf_(g0[k]) * u0[k] * w; a1[k] = g1[k] * sigmoidf_(g1[k]) * u1[k] * w; }
                v4u o; o.x = pk2(a0[0], a0[1]); o.y = pk2(a0[2], a0[3]); o.z = pk2(a1[0], a1[1]); o.w = pk2(a1[2], a1[3]);
                *(v4u*)(ACT + (size_t)(u.pm * 256 + rl) * FF + f0) = o;
            }
    }
};
struct EpiMoeDown {
    static constexpr bool PERM = true; static constexpr bool AFTER_DRAIN = false;
    bf16* Y2; const int* tok; const LAS int* ltab;
    __device__ __forceinline__ bool keep_acc(const Unit&) const { return false; }
    __device__ __forceinline__ void init(f32x4 (&acc)[2][2][4][2], const Unit&, int, int, int, int) const {
#pragma unroll
        for (int a = 0; a < 2; ++a)
#pragma unroll
            for (int b = 0; b < 2; ++b)
#pragma unroll
                for (int m = 0; m < 4; ++m)
#pragma unroll
                    for (int n = 0; n < 2; ++n) acc[a][b][m][n] = (f32x4){0.f, 0.f, 0.f, 0.f};
    }
    __device__ __forceinline__ void operator()(f32x4 (&acc)[2][2][4][2], const Unit& u, int wr, int wc, int fr, int fq) const {
        const LAS int* lt = ltab + (u.aux >> 16) * 256;
        const int col0 = u.pn * 256 + wc * 32 + 8 * fq;
        int trow[2][4];
#pragma unroll
        for (int ai = 0; ai < 2; ++ai)
#pragma unroll
            for (int m = 0; m < 4; ++m) trow[ai][m] = lt[ai * 128 + wr * 64 + m * 16 + fr];
#pragma unroll
        for (int ai = 0; ai < 2; ++ai)
#pragma unroll
            for (int m = 0; m < 4; ++m) {
                const int t = trow[ai][m];
                if (t >= 0) {
                    bf16* yp = Y2 + (size_t)t * D + col0;
#pragma unroll
                    for (int bj = 0; bj < 2; ++bj) { const f32x4 v0 = acc[ai][bj][m][0], v1 = acc[ai][bj][m][1];
                        v4u w; w.x = pk2(v0[0], v0[1]); w.y = pk2(v0[2], v0[3]); w.z = pk2(v1[0], v1[1]); w.w = pk2(v1[2], v1[3]);
                        *(v4u*)(yp + bj * 128) = w; }
                }
            }
    }
};

#define XB_TMO      128
#define XB_XCNT(j)  (256  + 64 * (j))
#define XB_XSUB(j)  (1280 + 64 * (j))
#define XB_XGEN(j)  (2304 + 64 * (j))
#define XB_TOP      3328
#define XB_TOPGEN   3392
#define XCD_BAR_WORDS 3456
#define XB_SPIN_CAP (1u << 18)

__device__ __forceinline__ unsigned xb_ld(unsigned* p)              { return __hip_atomic_load((gu32*)p, __ATOMIC_RELAXED, __HIP_MEMORY_SCOPE_AGENT); }
__device__ __forceinline__ unsigned xb_add(unsigned* p, unsigned v) { return __hip_atomic_fetch_add((gu32*)p, v, __ATOMIC_RELAXED, __HIP_MEMORY_SCOPE_AGENT); }
__device__ __forceinline__ unsigned xb_xcc_id() { return (unsigned)__builtin_amdgcn_s_getreg((3 << 11) | 20) & 0xFu; }
#define XB_SPIN(cond, bar) do { unsigned _sp = 0; while (cond) { __builtin_amdgcn_s_sleep(1); \
    if ((++_sp & 255u) == 0u) { if (xb_ld(&(bar)[XB_TMO])) break; if (_sp > XB_SPIN_CAP) { (void)xb_add(&(bar)[XB_TMO], 1u); break; } } } } while (0)

struct XcdBarrier {
    unsigned* bar; unsigned x;
    volatile LAS unsigned* st;
};
__device__ __forceinline__ XcdBarrier xcd_barrier_post(unsigned* bar, volatile LAS unsigned* st) {
    XcdBarrier b; b.bar = bar; b.x = xb_xcc_id(); b.st = st;
    if (threadIdx.x == 0) (void)xb_add(&bar[XB_XCNT(b.x)], 1u);
    return b;
}
__device__ __forceinline__ void xcd_barrier_complete(unsigned* bar, unsigned x, unsigned& nloc, unsigned& nx) {
    const unsigned G = gridDim.x * gridDim.y * gridDim.z;
    unsigned sum, cnt, mine, sp = 0u;
    for (;;) {
        sum = 0u; cnt = 0u; mine = 0u;
#pragma unroll
        for (unsigned j = 0; j < 16; ++j) { const unsigned c = xb_ld(&bar[XB_XCNT(j)]); sum += c; cnt += (c > 0u) ? 1u : 0u; mine = (j == x) ? c : mine; }
        if (sum == G) break;
        __builtin_amdgcn_s_sleep(1);
        if ((++sp & 255u) == 0u) { if (xb_ld(&bar[XB_TMO])) break; if (sp > XB_SPIN_CAP) { (void)xb_add(&bar[XB_TMO], 1u); break; } }
    }
    nloc = mine > 0u ? mine : 1u; nx = cnt > 0u ? cnt : 1u;
}
__device__ __forceinline__ void xcd_barrier(const XcdBarrier& b) {
    asm volatile("s_waitcnt vmcnt(0)" ::: "memory");
    __syncthreads();
    if (threadIdx.x == 0) {
        unsigned* bar = b.bar; unsigned bx_ = b.x;
        asm volatile("" : "+s"(bar), "+s"(bx_));
        __builtin_amdgcn_s_waitcnt(0);
        unsigned nloc = b.st[0], nx = b.st[1];
        if (nloc == 0u) { xcd_barrier_complete(bar, bx_, nloc, nx); b.st[0] = nloc; b.st[1] = nx; }
        const unsigned old = xb_add(&bar[XB_XSUB(bx_)], 1u);
        const unsigned gen = old / nloc;
        if (old + 1u == (gen + 1u) * nloc) {
            __builtin_amdgcn_fence(__ATOMIC_RELEASE, "agent");
            asm volatile("s_waitcnt vmcnt(0)" ::: "memory");
            const unsigned og = xb_add(&bar[XB_TOP], 1u);
            const unsigned tg = og / nx;
            if (og + 1u == (tg + 1u) * nx) xb_add(&bar[XB_TOPGEN], 1u);
            else XB_SPIN(xb_ld(&bar[XB_TOPGEN]) == tg, bar);
            __builtin_amdgcn_fence(__ATOMIC_ACQUIRE, "agent");
            xb_add(&bar[XB_XGEN(bx_)], 1u);
            asm volatile("s_waitcnt vmcnt(0)" ::: "memory");
        } else {
            XB_SPIN(xb_ld(&bar[XB_XGEN(bx_)]) == gen, bar);
            __builtin_amdgcn_fence(__ATOMIC_ACQUIRE, "agent");
            asm volatile("s_waitcnt vmcnt(0)" ::: "memory");
        }
    }
    __syncthreads();
}

__device__ __forceinline__ float wave_sum(float v) {
#pragma unroll
    for (int o = 1; o < 64; o <<= 1) v += __shfl_xor(v, o);
    return v;
}
struct Args { const float* in[17]; float* out; unsigned char* ws; int ph_lo, ph_hi, li, pad; };
struct CvtItem { const float* W; bf16* WT; int K, N, k0, n0, drow0, f8; const float* sc; };
enum { CVT_WIN = 0, CVT_S = 1, CVT_GU = 2, CVT_B = 3 };
__device__ __forceinline__ int cvt_count(int list) { return list == CVT_WIN ? 32 * 272 : list == CVT_S ? (1024 + 1024 + 2048) : list == CVT_GU ? 2 * 16384 : 16384; }
__device__ __forceinline__ CvtItem cvt_decode(const Args& a, int list, int l, int it) {
    CvtItem c; c.f8 = 0; c.sc = nullptr; unsigned char* wl = a.ws + WS_WL + (size_t)l * WL_STRIDE;
    if (list == CVT_WIN) { const int kb = it / 272, nb = it - kb * 272; c.W = a.in[2] + (size_t)l * D * INC; c.WT = (bf16*)(wl + WL_IN); c.K = D; c.N = INC; c.k0 = 64 * kb; c.n0 = 32 * nb; c.drow0 = c.n0;
        if (c.n0 >= N_BF) { c.f8 = 1; c.WT = (bf16*)(wl + WL_IN8); c.drow0 = c.n0 - N_BF; } return c; }
    if (list == CVT_B) { const int e = it >> 9, q = it & 511, kb = q >> 6, nb = q & 63; c.W = a.in[15] + ((size_t)l * NE + e) * FF * D; c.WT = (bf16*)(wl + WL_D) + (size_t)e * D * FF; c.K = FF; c.N = D; c.k0 = 64 * kb; c.n0 = 32 * nb; c.drow0 = c.n0; return c; }
    int r = it;
    if (list == CVT_S) {
    if (r < 1024) { c.W = a.in[4] + (size_t)l * 1024 * D; c.WT = (bf16*)(wl + WL_A); c.K = 1024; c.N = D; c.k0 = 64 * (r >> 6); c.n0 = 32 * (r & 63); c.drow0 = c.n0; return c; } r -= 1024;
    if (r < 1024) { c.W = a.in[6] + (size_t)l * 1024 * D; c.WT = (bf16*)(wl + WL_C); c.K = 1024; c.N = D; c.k0 = 64 * (r >> 6); c.n0 = 32 * (r & 63); c.drow0 = c.n0; return c; } r -= 1024;
    { c.W = a.in[7] + (size_t)l * D * D; c.WT = (bf16*)(wl + WL_O); c.K = D; c.N = D; c.k0 = 64 * (r >> 6); c.n0 = 32 * (r & 63); c.drow0 = c.n0; return c; }
    }
    const int up = r >= 16384; if (up) r -= 16384;
    const int e = r >> 9, q = r & 511, kb = q >> 4, nb = q & 15;
    c.W = a.in[up ? 14 : 13] + ((size_t)l * NE + e) * D * FF; c.WT = (bf16*)(wl + WL_GU) + (size_t)e * 1024 * D; c.K = D; c.N = FF; c.k0 = 64 * kb; c.n0 = 32 * nb;
    c.drow0 = (c.n0 >> 7) * 256 + (c.n0 & 127) + (up ? 128 : 0); c.sc = a.in[8] + (size_t)l * D; return c;
}
__device__ __forceinline__ void cvt_load(f32x4 (&v)[8], float& gq, const CvtItem& c, int lane) {
    gq = c.sc ? c.sc[c.k0 + lane] : 1.0f;
    const float* p = c.W + (size_t)(c.k0 + (lane >> 3)) * c.N + c.n0 + (lane & 7) * 4;
#pragma unroll
    for (int i = 0; i < 8; ++i) v[i] = __builtin_nontemporal_load((const f32x4*)(p + (size_t)(8 * i) * c.N));
}
__device__ __forceinline__ void cvt_emit(const f32x4 (&v)[8], float gq, const CvtItem& cur, LAS float* scr, int lane) {
    const int lr = lane >> 3, lc = (lane & 7) * 4, c8 = (lane & 7) * 8, nr = lane >> 3;
#pragma unroll
    for (int i = 0; i < 8; ++i) { LAS float* d = scr + (8 * i + lr) * 33 + lc; d[0] = v[i].x; d[1] = v[i].y; d[2] = v[i].z; d[3] = v[i].w; }
    scr[64 * 33 + lane] = gq;
    LDS_WAIT(); asm volatile("" ::: "memory");
    if (cur.f8) {
#pragma unroll
        for (int jj = 0; jj < 4; ++jj) { const int n = nr + 8 * jj; const LAS float* s = scr + c8 * 33 + n;
            v2u o; o.x = pk4_fp8(s[0 * 33] * W8_SCALE, s[1 * 33] * W8_SCALE, s[2 * 33] * W8_SCALE, s[3 * 33] * W8_SCALE); o.y = pk4_fp8(s[4 * 33] * W8_SCALE, s[5 * 33] * W8_SCALE, s[6 * 33] * W8_SCALE, s[7 * 33] * W8_SCALE);
            __builtin_nontemporal_store(o, (GAS v2u*)((unsigned char*)cur.WT + (size_t)(cur.drow0 + n) * cur.K + cur.k0 + c8)); }
    } else {
    const LAS float* gs = scr + 64 * 33 + c8;
#pragma unroll
    for (int jj = 0; jj < 4; ++jj) { const int n = nr + 8 * jj; const LAS float* s = scr + c8 * 33 + n;
        v4u o; o.x = pk2(s[0 * 33] * gs[0], s[1 * 33] * gs[1]); o.y = pk2(s[2 * 33] * gs[2], s[3 * 33] * gs[3]); o.z = pk2(s[4 * 33] * gs[4], s[5 * 33] * gs[5]); o.w = pk2(s[6 * 33] * gs[6], s[7 * 33] * gs[7]);
        __builtin_nontemporal_store(o, (GAS v4u*)(cur.WT + (size_t)(cur.drow0 + n) * cur.K + cur.k0 + c8)); }
    }
    LDS_WAIT(); asm volatile("" ::: "memory");
}
__device__ __forceinline__ void cvt_run(const Args& a, int list, int l, int w, int nw, LAS float* scr, int lane, int it_lo = 0, int it_hi = 1 << 30, int pace = 0) {
    const int T = cvt_count(list) < it_hi ? cvt_count(list) : it_hi;
    int it = it_lo + w;
    CvtItem cA, cB, cC; f32x4 vA[8], vB[8], vC[8]; float gA = 1.f, gB = 1.f, gC = 1.f;
    bool hA = it < T, hB, hC;
    if (hA) { cA = cvt_decode(a, list, l, it); cvt_load(vA, gA, cA, lane); } it += nw;
    hB = it < T; if (hB) { cB = cvt_decode(a, list, l, it); cvt_load(vB, gB, cB, lane); } it += nw;
    while (hA) {
        hC = it < T; if (hC) { cC = cvt_decode(a, list, l, it); cvt_load(vC, gC, cC, lane); } it += nw;
        cvt_emit(vA, gA, cA, scr, lane); for (int z = 0; z < pace; ++z) __builtin_amdgcn_s_sleep(32);
        if (!hB) break;
        hA = it < T; if (hA) { cA = cvt_decode(a, list, l, it); cvt_load(vA, gA, cA, lane); } it += nw;
        cvt_emit(vB, gB, cB, scr, lane); for (int z = 0; z < pace; ++z) __builtin_amdgcn_s_sleep(32);
        if (!hC) break;
        hB = it < T; if (hB) { cB = cvt_decode(a, list, l, it); cvt_load(vB, gB, cB, lane); } it += nw;
        cvt_emit(vC, gC, cC, scr, lane); for (int z = 0; z < pace; ++z) __builtin_amdgcn_s_sleep(32);
    }
}
__device__ __forceinline__ void norm_row(const float* xrow, const bf16* y0, const bf16* y1, bf16* xo, const float* g, bf16* hb, float* of, int lane, unsigned char* h8 = nullptr, const bf16* xh = nullptr) {
    f32x4 v[8]; float s = 0.f;
    if (xh) {
#pragma unroll
        for (int j = 0; j < 8; ++j) { const v2u w = ((const v2u*)xh)[lane + 64 * j]; v[j] = (f32x4){bflo(w.x), bfhi(w.x), bflo(w.y), bfhi(w.y)}; }
    } else {
#pragma unroll
    for (int j = 0; j < 8; ++j) { v[j] = ((const f32x4*)xrow)[lane + 64 * j]; }
    }
    if (y0) {
        v2u a0[8], a1[8];
#pragma unroll
        for (int j = 0; j < 8; ++j) { a0[j] = ((const v2u*)y0)[lane + 64 * j]; a1[j] = ((const v2u*)y1)[lane + 64 * j]; }
#pragma unroll
        for (int j = 0; j < 8; ++j) { v[j].x += bflo(a0[j].x); v[j].y += bfhi(a0[j].x); v[j].z += bflo(a0[j].y); v[j].w += bfhi(a0[j].y); }
#pragma unroll
        for (int j = 0; j < 8; ++j) { v[j].x += bflo(a1[j].x); v[j].y += bfhi(a1[j].x); v[j].z += bflo(a1[j].y); v[j].w += bfhi(a1[j].y); }
    }
#pragma unroll
    for (int j = 0; j < 8; ++j) s += (v[j].x * v[j].x + v[j].y * v[j].y) + (v[j].z * v[j].z + v[j].w * v[j].w);
    if (xo) {
#pragma unroll
        for (int j = 0; j < 8; ++j) { v2u w; w.x = pk2(v[j].x, v[j].y); w.y = pk2(v[j].z, v[j].w); ((v2u*)xo)[lane + 64 * j] = w; }
    }
    const float rstd = 1.0f / sqrtf(wave_sum(s) * (1.f / D) + NORM_EPS);
#pragma unroll
    for (int j = 0; j < 8; ++j) {
        const f32x4 gg = ((const f32x4*)g)[lane + 64 * j];
        const f32x4 o = v[j] * rstd * gg;
        if (hb) { v2u w; w.x = pk2(o.x, o.y); w.y = pk2(o.z, o.w); ((v2u*)hb)[lane + 64 * j] = w; if (h8) ((unsigned*)h8)[lane + 64 * j] = pk4_fp8(o.x, o.y, o.z, o.w); }
        else ((f32x4*)of)[lane + 64 * j] = o;
    }
}


__device__ __forceinline__ void phase_prologue(const Args& a, LAS unsigned char* lds, int vcu, int G, int wave, int lane) {
    unsigned char* ws = a.ws;
    LAS float* scr = (LAS float*)(lds + wave * 16384);
    const int gw = vcu * NWAVES + wave, NGW = G * NWAVES;
    cvt_run(a, CVT_WIN, 0, gw, NGW, scr, lane);
    const int gt = gw * 64 + lane, NGT = NGW * 64;
    for (int idx = gt; idx < DEPTH * 48 * D; idx += NGT) {
        const int l = idx / (48 * D), rem = idx - l * 48 * D, n = rem / D, k = rem - n * D;
        float w = 0.f; if (n < 4) w = a.in[9][((size_t)l * D + k) * 4 + n]; else if (n < 36) w = a.in[11][((size_t)l * D + k) * 32 + (n - 4)];
        const unsigned hi = f2bf(w); const float lo = w - __builtin_bit_cast(float, hi << 16);
        bf16* wr = (bf16*)(ws + WS_WL + (size_t)l * WL_STRIDE + WL_R);
        wr[n * D + k] = (bf16)hi; wr[48 * D + n * D + k] = (bf16)f2bf(lo);
    }
    for (int idx = gt; idx < SEQ * 8; idx += NGT) {
        const int pos = idx >> 3, i = idx & 7;
        const float inv = i == 0 ? 1.0f : i == 1 ? 0x1.8d275ep-3f : i == 2 ? 0x1.341190p-5f : i == 3 ? 0x1.ddee9cp-8f : i == 4 ? 0x1.72ba44p-10f : i == 5 ? 0x1.1f91f0p-12f : i == 6 ? 0x1.be2188p-15f : 0x1.5a0f4ep-17f;
        const float ang = (float)pos * inv;
        const double ad = (double)ang, kq = __builtin_rint(ad * 0.63661977236758134308);
        const double rr = __builtin_fma(-kq, 1.5707963267948966192, ad) - kq * 6.123233995736766e-17, r2 = rr * rr;
        const double sp = rr * (1.0 + r2 * (-1.0 / 6 + r2 * (1.0 / 120 + r2 * (-1.0 / 5040 + r2 * (1.0 / 362880 + r2 * (-1.0 / 39916800 + r2 * (1.0 / 6227020800.0)))))));
        const double cp = 1.0 + r2 * (-0.5 + r2 * (1.0 / 24 + r2 * (-1.0 / 720 + r2 * (1.0 / 40320 + r2 * (-1.0 / 3628800 + r2 * (1.0 / 479001600.0 + r2 * (-1.0 / 87178291200.0)))))));
        const int qd = (int)kq & 3;
        const double sn = qd == 0 ? sp : qd == 1 ? cp : qd == 2 ? -sp : -cp, cs = qd == 0 ? cp : qd == 1 ? -sp : qd == 2 ? -cp : sp;
        float* rp = (float*)(ws + WS_ROPE) + (size_t)pos * 16;
        rp[i] = (float)cs; rp[8 + i] = (float)sn;
    }
    for (int m = gw; m < M; m += NGW) norm_row(a.in[0] + (size_t)m * D, nullptr, nullptr, nullptr, a.in[1], (bf16*)(ws + WS_H) + (size_t)m * D, nullptr, lane, ws + WS_H8 + (size_t)m * D);
}

constexpr int KS_STRIDE = 144, VT_OFF = 256 * KS_STRIDE, VT_STRIDE = 520;
__device__ __forceinline__ int crow(int r, int hi) { return (r & 3) + 8 * (r >> 2) + 4 * hi; }
__device__ __forceinline__ void attn_side_work(const Args& a, int l, LAS unsigned char* lds, int G, int vcu, int wave, int lane, int gu_lo);
__device__ __forceinline__ void phase_attn_conv(const Args& a, int l, LAS unsigned char* lds, int G, int vcu, int tid, int wave, int lane, int gu_lo) {
#define side_work() attn_side_work(a, l, lds, G, vcu, wave, lane, gu_lo)
    unsigned char* ws = a.ws;
    const bf16* P = (const bf16*)(ws + WS_P);
    bf16* AO = (bf16*)(ws + WS_AO);
    const float* sinks = a.in[3] + l * 16;
    const int j = lane & 31, h = lane >> 5;
    constexpr float LOG2E = 1.4426950408889634f;
    {   const int unit = blockIdx.x;
        const int qb = unit & 31, kvh = (unit >> 5) & 3, b = unit >> 7;
        const int q0 = qb * 128; const size_t rowbase = (size_t)b * SEQ;
#pragma unroll
        for (int it = 0; it < 4; ++it) {
            const int idx = it * 512 + tid, kl = idx >> 3, ch = idx & 7, pos = q0 - 128 + kl;
            v4u kv = {0u, 0u, 0u, 0u}, vv = kv;
            if (pos >= 0) { const bf16* src = P + (rowbase + pos) * INC + kvh * 64 + ch * 8; kv = *(const v4u*)(src + C_K); vv = *(const v4u*)(src + C_V); }
            *(LAS v4u*)(lds + kl * KS_STRIDE + ch * 16) = kv;
            LAS unsigned short* vt = (LAS unsigned short*)(lds + VT_OFF + (ch * 8) * VT_STRIDE + kl * 2);
            vt[0 * (VT_STRIDE / 2)] = (unsigned short)(vv.x & 0xffffu); vt[1 * (VT_STRIDE / 2)] = (unsigned short)(vv.x >> 16);
            vt[2 * (VT_STRIDE / 2)] = (unsigned short)(vv.y & 0xffffu); vt[3 * (VT_STRIDE / 2)] = (unsigned short)(vv.y >> 16);
            vt[4 * (VT_STRIDE / 2)] = (unsigned short)(vv.z & 0xffffu); vt[5 * (VT_STRIDE / 2)] = (unsigned short)(vv.z >> 16);
            vt[6 * (VT_STRIDE / 2)] = (unsigned short)(vv.w & 0xffffu); vt[7 * (VT_STRIDE / 2)] = (unsigned short)(vv.w >> 16);
        }
        __syncthreads();
        if (wave >= 4) side_work();
        else
#pragma unroll 1
        for (int tk = 0; tk < 4; ++tk) {
            const int task = wave + 4 * tk, hql = task >> 2, sub = task & 3, r0 = sub * 32, head = kvh * 4 + hql;
            const bf16* qrow = P + (rowbase + q0 + r0 + j) * INC + C_Q + head * 64 + h * 8;
            bf16x8 qf[4];
#pragma unroll
            for (int c = 0; c < 4; ++c) qf[c] = *(const bf16x8*)(qrow + 16 * c);
            f32x16 s[5];
#pragma unroll
            for (int kbi = 0; kbi < 5; ++kbi) {
                const int kl0 = 32 * (sub + kbi);
                f32x16 acc = {0.f, 0.f, 0.f, 0.f, 0.f, 0.f, 0.f, 0.f, 0.f, 0.f, 0.f, 0.f, 0.f, 0.f, 0.f, 0.f};
#pragma unroll
                for (int c = 0; c < 4; ++c) {
                    const bf16x8 kf = *(const LAS bf16x8*)(lds + (kl0 + j) * KS_STRIDE + (16 * c + 8 * h) * 2);
                    acc = __builtin_amdgcn_mfma_f32_32x32x16_bf16(kf, qf[c], acc, 0, 0, 0);
                }
                s[kbi] = acc;
                __builtin_amdgcn_sched_barrier(0);
            }
            const float sink = sinks[head] * LOG2E;
            float mx = sink;
#pragma unroll
            for (int kbi = 0; kbi < 5; ++kbi) {
                const int base = (qb == 0 && sub + kbi < 4) ? -4096 : (j + 128 - 32 * kbi - 4 * h);
#pragma unroll
                for (int i = 0; i < 16; ++i) {
                    const int dd = base - ((i & 3) + 8 * (i >> 2)), tt = min(dd, 127 - dd);
                    const float pen = __builtin_bit_cast(float, 0x7f800000u | ((unsigned)(tt >> 31) & 0x80000000u));
                    const float v = __builtin_fminf(s[kbi][i] * LOG2E, pen); s[kbi][i] = v; mx = __builtin_fmaxf(mx, v);
                }
            }
            mx = __builtin_fmaxf(mx, __shfl_xor(mx, 32));
            float lsum = 0.f;
#pragma unroll
            for (int kbi = 0; kbi < 5; ++kbi)
#pragma unroll
                for (int i = 0; i < 16; ++i) { const float p = __builtin_amdgcn_exp2f(s[kbi][i] - mx); s[kbi][i] = p; lsum += p; }
            lsum += __shfl_xor(lsum, 32);
            lsum += __builtin_amdgcn_exp2f(sink - mx);
            f32x16 o[2];
#pragma unroll
            for (int db = 0; db < 2; ++db) o[db] = (f32x16){0.f, 0.f, 0.f, 0.f, 0.f, 0.f, 0.f, 0.f, 0.f, 0.f, 0.f, 0.f, 0.f, 0.f, 0.f, 0.f};
#pragma unroll
            for (int kbi = 0; kbi < 5; ++kbi)
#pragma unroll
                for (int st = 0; st < 2; ++st) {
                    v4u pw; pw.x = pk2i(s[kbi][8 * st + 0], s[kbi][8 * st + 1]); pw.y = pk2i(s[kbi][8 * st + 2], s[kbi][8 * st + 3]);
                    pw.z = pk2i(s[kbi][8 * st + 4], s[kbi][8 * st + 5]); pw.w = pk2i(s[kbi][8 * st + 6], s[kbi][8 * st + 7]);
                    const bf16x8 pf = __builtin_bit_cast(bf16x8, pw);
#pragma unroll
                    for (int db = 0; db < 2; ++db) {
                        const int addr = VT_OFF + (32 * db + j) * VT_STRIDE + (32 * (sub + kbi) + 16 * st + 4 * h) * 2;
                        const s16x4 lo = *(const LAS s16x4*)(lds + addr), hi = *(const LAS s16x4*)(lds + addr + 16);
                        const bf16x8 vf = __builtin_shufflevector(lo, hi, 0, 1, 2, 3, 4, 5, 6, 7);
                        o[db] = __builtin_amdgcn_mfma_f32_32x32x16_bf16(vf, pf, o[db], 0, 0, 0);
                    }
                    __builtin_amdgcn_sched_barrier(0);
                }
            const float inv = 1.0f / lsum;
            bf16* orow = AO + (rowbase + q0 + r0 + j) * 1024 + head * 64 + 4 * h;
#pragma unroll
            for (int db = 0; db < 2; ++db)
#pragma unroll
                for (int g = 0; g < 4; ++g) {
                    v2u w; w.x = pk2i(o[db][4 * g + 0] * inv, o[db][4 * g + 1] * inv); w.y = pk2i(o[db][4 * g + 2] * inv, o[db][4 * g + 3] * inv);
                    *(v2u*)(orow + 32 * db + 8 * g) = w;
                }
        }
        __syncthreads();
    }
}
__device__ __forceinline__ void attn_side_work(const Args& a, int l, LAS unsigned char* lds, int G, int vcu, int wave, int lane_in, int gu_lo) {
    int lane = lane_in; asm volatile("" : "+v"(lane));
    unsigned char* ws = a.ws;
    const bf16* P = (const bf16*)(ws + WS_P);
    bf16* CV = (bf16*)(ws + WS_CV);
    const float* cw = a.in[5] + (size_t)l * 3 * 1024;
    for (int it = blockIdx.x * 256 + (wave - 4) * 64 + lane; it < 1024 * 128; it += G * 256) {
        const int ch = it & 127, t0 = (it >> 7) * 8, c0 = ch * 8;
        float w0[8], w1[8], w2[8], u1[8], u2[8];
#pragma unroll
        for (int e = 0; e < 8; ++e) { w0[e] = cw[c0 + e]; w1[e] = cw[1024 + c0 + e]; w2[e] = cw[2048 + c0 + e]; u1[e] = 0.f; u2[e] = 0.f; }
        if ((t0 & (SEQ - 1)) != 0) {
            const bf16* p2 = P + (size_t)(t0 - 2) * INC + c0; const bf16* p1 = p2 + INC;
            const v4u c2 = *(const v4u*)(p2 + C_CC), x2 = *(const v4u*)(p2 + C_CX), c1 = *(const v4u*)(p1 + C_CC), x1 = *(const v4u*)(p1 + C_CX);
            u2[0] = bflo(c2.x) * bflo(x2.x); u2[1] = bfhi(c2.x) * bfhi(x2.x); u2[2] = bflo(c2.y) * bflo(x2.y); u2[3] = bfhi(c2.y) * bfhi(x2.y);
            u2[4] = bflo(c2.z) * bflo(x2.z); u2[5] = bfhi(c2.z) * bfhi(x2.z); u2[6] = bflo(c2.w) * bflo(x2.w); u2[7] = bfhi(c2.w) * bfhi(x2.w);
            u1[0] = bflo(c1.x) * bflo(x1.x); u1[1] = bfhi(c1.x) * bfhi(x1.x); u1[2] = bflo(c1.y) * bflo(x1.y); u1[3] = bfhi(c1.y) * bfhi(x1.y);
            u1[4] = bflo(c1.z) * bflo(x1.z); u1[5] = bfhi(c1.z) * bfhi(x1.z); u1[6] = bflo(c1.w) * bflo(x1.w); u1[7] = bfhi(c1.w) * bfhi(x1.w);
        }
#pragma unroll
        for (int t = 0; t < 8; ++t) {
            const bf16* pp = P + (size_t)(t0 + t) * INC + c0;
            const v4u cc = *(const v4u*)(pp + C_CC), cx = *(const v4u*)(pp + C_CX), cb = *(const v4u*)(pp + C_CB);
            float u0[8], bb[8], y[8];
            u0[0] = bflo(cc.x) * bflo(cx.x); u0[1] = bfhi(cc.x) * bfhi(cx.x); u0[2] = bflo(cc.y) * bflo(cx.y); u0[3] = bfhi(cc.y) * bfhi(cx.y);
            u0[4] = bflo(cc.z) * bflo(cx.z); u0[5] = bfhi(cc.z) * bfhi(cx.z); u0[6] = bflo(cc.w) * bflo(cx.w); u0[7] = bfhi(cc.w) * bfhi(cx.w);
            bb[0] = bflo(cb.x); bb[1] = bfhi(cb.x); bb[2] = bflo(cb.y); bb[3] = bfhi(cb.y); bb[4] = bflo(cb.z); bb[5] = bfhi(cb.z); bb[6] = bflo(cb.w); bb[7] = bfhi(cb.w);
#pragma unroll
            for (int e = 0; e < 8; ++e) { y[e] = bb[e] * (w0[e] * u2[e] + w1[e] * u1[e] + w2[e] * u0[e]); u2[e] = u1[e]; u1[e] = u0[e]; }
            v4u o; o.x = pk2(y[0], y[1]); o.y = pk2(y[2], y[3]); o.z = pk2(y[4], y[5]); o.w = pk2(y[6], y[7]);
            *(v4u*)(CV + (size_t)(t0 + t) * 1024 + c0) = o;
        }
    }
    if (l == 0) cvt_run(a, CVT_S, 0, vcu * 4 + (wave - 4), G * 4, (LAS float*)(lds + 81920 + (wave - 4) * 8704), lane);
    cvt_run(a, CVT_GU, l, vcu * 4 + (wave - 4), G * 4, (LAS float*)(lds + 81920 + (wave - 4) * 8704), lane, gu_lo, GU_SPLIT2);
}

__device__ __forceinline__ void phase_norm_router(const Args& a, int l, LAS unsigned char* lds, int G, int vcu, int tid, int wave, int lane, int bank) {
    unsigned char* ws = a.ws;
    const bf16* HX = (const bf16*)(ws + WS_H);
    const float* part = (const float*)(ws + WS_PART);
    const bf16* Wh = (const bf16*)(ws + WS_WL + (size_t)l * WL_STRIDE + WL_R); const bf16* Wl = Wh + 48 * D;
    const float* bg = a.in[10] + l * 4; const float* br = a.in[12] + l * 32;
    unsigned* cnt = (unsigned*)(ws + WS_CTL) + CW_CNT + l * 8192 + (blockIdx.x & 7) * 1024;
    int* tok = (int*)(ws + WS_TOK); float* wgt = (float*)(ws + WS_WGT); float* rsl = (float*)(ws + WS_RSL);
    LAS float* red = (LAS float*)lds;
    LAS float* lg = (LAS float*)(lds + 49152);
    LAS float* rs = (LAS float*)(lds + 49152 + 6144);
    const int r = lane & 15, q = lane >> 4;
    {   const int blk = blockIdx.x;
        const int row0 = blk * 32;
        if (tid < 32) { const f32x4* pp = (const f32x4*)(part + (size_t)(row0 + tid) * 32); float t = 0.f;
#pragma unroll
            for (int i = 0; i < 8; ++i) { const f32x4 v = pp[i]; t += (v.x + v.y) + (v.z + v.w); }
            rs[tid] = 1.0f / sqrtf(t * (1.f / D) + NORM_EPS); }
        { const float* pl = (const float*)(ws + WS_PARTL) + (size_t)row0 * 8 * 48;
          for (int idx = tid; idx < 32 * 48; idx += 512) { const int rr = idx / 48, n = idx - rr * 48; const float* p = pl + (size_t)rr * 8 * 48 + n; float t = 0.f;
#pragma unroll
              for (int pn = 0; pn < 8; ++pn) t += p[pn * 48];
              lg[idx] = t; } }
        __syncthreads();
        if (wave >= 1) { int ln = lane; asm volatile("" : "+v"(ln)); cvt_run(a, CVT_GU, l, vcu * 7 + (wave - 1), G * 7, (LAS float*)(lds + 65536 + (wave - 1) * 8704), ln, GU_SPLIT2, 1 << 30); }
        if (tid < 32) {
            const float rsd = rs[tid]; const LAS float* lr = lg + tid * 48;
            float gl0 = lr[0] * rsd + bg[0], gl1 = lr[1] * rsd + bg[1], gl2 = lr[2] * rsd + bg[2], gl3 = lr[3] * rsd + bg[3];
            int gi = 0; float gm = gl0;
            if (gl1 > gm) { gm = gl1; gi = 1; } if (gl2 > gm) { gm = gl2; gi = 2; } if (gl3 > gm) { gm = gl3; gi = 3; }
            const float gw = 1.0f / (__expf(gl0 - gm) + __expf(gl1 - gm) + __expf(gl2 - gm) + __expf(gl3 - gm));
            float sv[8];
#pragma unroll
            for (int e = 0; e < 8; ++e) sv[e] = lr[4 + gi * 8 + e] * rsd + br[gi * 8 + e];
            int i1 = 0; float m1 = sv[0];
#pragma unroll
            for (int e = 1; e < 8; ++e) if (sv[e] > m1) { m1 = sv[e]; i1 = e; }
            int i2 = (i1 + 1) & 7; float m2 = -INFINITY;
#pragma unroll
            for (int e = 0; e < 8; ++e) if (e != i1 && sv[e] > m2) { m2 = sv[e]; i2 = e; }
            const float p2 = __expf(m2 - m1), w1 = gw / (1.0f + p2), w2 = gw * p2 / (1.0f + p2);
            const int e1 = gi * 8 + i1, e2 = gi * 8 + i2, token = row0 + tid;
            const unsigned pos1 = __hip_atomic_fetch_add(cnt + e1 * 32, 1u, RLX_AGENT), pos2 = __hip_atomic_fetch_add(cnt + e2 * 32, 1u, RLX_AGENT);
            const int li1 = e1 * M + (blockIdx.x & 7) * SHARD_CAP + (int)pos1, li2 = e2 * M + (blockIdx.x & 7) * SHARD_CAP + (int)pos2;
            tok[li1] = token * 2; wgt[li1] = w1; rsl[li1] = rsd;
            tok[li2] = token * 2 + 1; wgt[li2] = w2; rsl[li2] = rsd;
        }
        __syncthreads();
    }
}

__device__ __forceinline__ int slot_index(const LAS int* sp, int e, int pos) {
    int sh = 0;
#pragma unroll
    for (int k = 1; k < NSHARD; ++k) sh += (pos >= sp[e * 9 + k]) ? 1 : 0;
    return e * M + sh * SHARD_CAP + pos - sp[e * 9 + sh];
}
__device__ __forceinline__ int moe_tables(const Args& a, int l, LAS unsigned char* lds, int tid) {
    LAS int* tile_e = (LAS int*)(lds + TILE_OFF); LAS int* tile_mt = tile_e + 128; LAS int* lcnt = tile_e + 256; LAS int* lnt = tile_e + 288;
    const unsigned* cnt = (const unsigned*)(a.ws + WS_CTL) + CW_CNT + l * 8192;
    if (tid < 64) {
        LAS int* sp = tile_e + 320;
        int c = 0;
        if (tid < 32) { unsigned cs[NSHARD];
#pragma unroll
            for (int sh = 0; sh < NSHARD; ++sh) cs[sh] = __hip_atomic_load(cnt + (sh * 32 + tid) * 32, RLX_AGENT);
            sp[tid * 9] = 0;
#pragma unroll
            for (int sh = 0; sh < NSHARD; ++sh) { c += (int)cs[sh]; sp[tid * 9 + sh + 1] = c; } }
        const int n = (c + 255) >> 8;
        int inc = n;
#pragma unroll
        for (int o = 1; o < 32; o <<= 1) { const int t = __shfl_up(inc, o); if (tid >= o) inc += t; }
        const int start = inc - n;
        if (tid < 32) { lcnt[tid] = c;
#pragma unroll 1
            for (int mt = 0; mt < n; ++mt) { if (start + mt < 128) { tile_e[start + mt] = tid; tile_mt[start + mt] = mt; } } }
        if (tid == 31) lnt[0] = inc < 128 ? inc : 128;
    }
    __syncthreads();
    return lnt[0];
}

__global__ void __launch_bounds__(NWAVES * 64, 2) mk_fwd(Args args) {
    extern __shared__ __attribute__((aligned(16))) unsigned char lds_raw[];
    LAS unsigned char* lds = (LAS unsigned char*)lds_raw;
    volatile LAS unsigned* MISC = (volatile LAS unsigned*)(lds + MISC_OFF);
    const int G = gridDim.x; const int bx = blockIdx.x; const int vcu = (G % 8 == 0) ? (bx % 8) * (G / 8) + bx / 8 : bx;
    unsigned char* ws = args.ws;
    gu32* ctl = (gu32*)(ws + WS_CTL);
    for (int u = threadIdx.x; u < (LDS_BYTES - LDSCTL_OFF) / 4; u += NWAVES * 64) ((LAS unsigned*)(lds + LDSCTL_OFF))[u] = 0u;
    __syncthreads();
    XcdBarrier bar; bar.bar = (unsigned*)ctl + CW_BAR; bar.x = 0; bar.st = nullptr;
    if (MK_N_LAUNCHES == 1) bar = xcd_barrier_post((unsigned*)ctl + CW_BAR, MISC + 8);
#ifndef MK_BAR_REP
#define MK_BAR_REP 1
#endif
#define GRID_BAR() do { if (MK_N_LAUNCHES == 1) { _Pragma("unroll 1") for (int br_ = 0; br_ < MK_BAR_REP; ++br_) xcd_barrier(bar); } } while (0)
#ifndef MK_STRETCH_PH
#define MK_STRETCH_PH -1
#endif
#ifndef MK_STRETCH_MUL
#define MK_STRETCH_MUL 3
#endif
#ifndef MK_STRETCH_ROLE
#define MK_STRETCH_ROLE 0
#endif
#define STRETCH(pid) do { if (MK_STRETCH_PH >= 0 && (pid) == MK_STRETCH_PH && stretch_ok) { asm volatile("s_waitcnt vmcnt(0)" ::: "memory"); if (threadIdx.x == 0) { \
        const unsigned long long t1_ = __builtin_amdgcn_s_memrealtime(), t0_ = (unsigned long long)MISC[16] | ((unsigned long long)MISC[17] << 32), dt_ = (t1_ - t0_) * MK_STRETCH_MUL; \
        while (__builtin_amdgcn_s_memrealtime() - t1_ < dt_) __builtin_amdgcn_s_sleep(8); } } } while (0)
#define STAMP0() do { if (MK_STRETCH_PH >= 0 && threadIdx.x == 0) { const unsigned long long t_ = __builtin_amdgcn_s_memrealtime(); MISC[16] = (unsigned)t_; MISC[17] = (unsigned)(t_ >> 32); } } while (0)
#define GRID_BAR_P(pid) do { STRETCH(pid); GRID_BAR(); STAMP0(); } while (0)
    bool stretch_ok = true; (void)stretch_ok;
    STAMP0();
    const int lo = args.ph_lo, hi = args.ph_hi;
#ifndef PH_MASK
#define PH_MASK 0x1ff
#endif
#define PHON(j) (((PH_MASK) >> (j)) & 1)
#define IN(k) (lo <= (k) && (k) < hi)
#define BOTH(k) (IN(k) && IN((k) + 1))

#define PHASE_IDS() int tid_ = threadIdx.x; asm volatile("" : "+v"(tid_)); const int tid = tid_, lane = tid & 63, wave = __builtin_amdgcn_readfirstlane(tid >> 6); (void)tid; (void)lane; (void)wave
    if (PHON(0) && IN(0)) { PHASE_IDS(); REP(0, true) phase_prologue(args, lds, vcu, G, wave, lane); if (BOTH(0)) GRID_BAR_P(0); }

    constexpr int GU_SPLIT = 24576;
    constexpr int WIN_EARLY = 2560;
    constexpr int NG2 = 218;
    for (int l = 0; l < DEPTH; ++l) {
        const int pb = 1 + 8 * l;
        unsigned char* wl = ws + WS_WL + (size_t)l * WL_STRIDE;
        if (PHON(1) && IN(pb + 0)) {
            PHASE_IDS();
            if (bx >= NG2) { cvt_run(args, CVT_GU, l, (bx - NG2) * NWAVES + wave, (256 - NG2) * NWAVES, (LAS float*)(lds + wave * 16384), lane, 0, l == 0 ? GU_SPLIT + 2048 : GU_SPLIT, MK_PACE2);
                if (l + 1 < DEPTH) cvt_run(args, CVT_WIN, l + 1, (bx - NG2) * NWAVES + wave, (256 - NG2) * NWAVES, (LAS float*)(lds + wave * 16384), lane, 0, WIN_EARLY); }
            if (bx < NG2) {
            { SchedPlain S; S.T.init(M, N_BF, NG2, bx); S.A = (const char*)(ws + WS_H); S.Bt = (const char*)(wl + WL_IN); S.tstep = (size_t)256 * D * 2;
              EpiInProj E{(bf16*)(ws + WS_P), (const float*)(ws + WS_ROPE), 0, 1.0f};
              REP(1, true) pg8::gemm_phase<EpiInProj, SchedPlain, true, false>(lds, D, S, E); }
            { SchedPlain S; S.T.init(M, N_F8, NG2, NG2 - 1 - bx); S.A = (const char*)(ws + WS_H8); S.Bt = (const char*)(wl + WL_IN8); S.tstep = (size_t)256 * D;
              EpiInProj E{(bf16*)(ws + WS_P), (const float*)(ws + WS_ROPE), N_BF / 256, 1.0f / W8_SCALE};
              REP(1, true) pg8::gemm_phase<EpiInProj, SchedPlain, true, false, true>(lds, D / 2, S, E); }
            }
            if (MK_STRETCH_ROLE) stretch_ok = (MK_STRETCH_ROLE == 1) == (bx < NG2);
            if (BOTH(pb + 0)) GRID_BAR_P(pb + 0); else STRETCH(pb + 0);
            stretch_ok = true;
        }
        if (PHON(2) && IN(pb + 1)) { PHASE_IDS(); REP(2, true) phase_attn_conv(args, l, lds, G, vcu, tid, wave, lane, l == 0 ? GU_SPLIT + 2048 : GU_SPLIT); if (BOTH(pb + 1)) GRID_BAR_P(pb + 1); else STRETCH(pb + 1); }
        if (PHON(3) && IN(pb + 2)) {
            SchedPair S; S.T.init(M, D, G, bx); S.A0 = (const char*)(ws + WS_AO); S.A1 = (const char*)(ws + WS_CV); S.B0 = (const char*)(wl + WL_A); S.B1 = (const char*)(wl + WL_C); S.tstep = (size_t)256 * 1024 * 2;
            EpiMerge E{(const bf16*)(ws + WS_P), (bf16*)(ws + WS_MG)};
            REP(3, true) pg8::gemm_phase<EpiMerge, SchedPair, true, false>(lds, 1024, S, E);
            if (BOTH(pb + 2)) GRID_BAR_P(pb + 2); else STRETCH(pb + 2);
        }
        if (PHON(4) && IN(pb + 3)) {
            SchedPlain S; S.T.init(M, D, G, bx); S.A = (const char*)(ws + WS_MG); S.Bt = (const char*)(wl + WL_O); S.tstep = (size_t)256 * D * 2;
            EpiResHx E{args.in[0], (bf16*)(ws + WS_XRES), (bf16*)(ws + WS_H), args.in[8] + (size_t)l * D, (float*)(ws + WS_PART), (const bf16*)(wl + WL_R), (float*)(ws + WS_PARTL), l == 0 ? nullptr : (const bf16*)(ws + WS_XRES)};
            REP(4, l == 0) pg8::gemm_phase<EpiResHx, SchedPlain, true, false>(lds, D, S, E);
            if (BOTH(pb + 3)) GRID_BAR_P(pb + 3); else STRETCH(pb + 3);
        }
        if (PHON(5) && IN(pb + 4)) { PHASE_IDS(); REP(5, true) phase_norm_router(args, l, lds, G, vcu, tid, wave, lane, rep_); if (BOTH(pb + 4)) GRID_BAR_P(pb + 4); else STRETCH(pb + 4); }
        if (PHON(6) && IN(pb + 5)) {
            PHASE_IDS();
            const int ntiles = moe_tables(args, l, lds, tid);
            int NG7; { const int th = 4 * ((ntiles + 7) >> 3), rounds = (th + 27) / 28, per = (th + rounds - 1) / rounds; NG7 = 8 * per; }
            if (bx >= NG7) { const int cw = (bx - NG7) * NWAVES + wave, cn = (256 - NG7) * NWAVES; LAS float* scr = (LAS float*)(lds + wave * 16384);
                cvt_run(args, CVT_B, l, cw, cn, scr, lane, 0, 1 << 30, MK_PACE7);
                if (l + 1 < DEPTH) { cvt_run(args, CVT_WIN, l + 1, cw, cn, scr, lane, WIN_EARLY, 1 << 30, MK_PACE7); if ((ntiles * 8 + 223) / 224 != (ntiles * 8 + 255) / 256) cvt_run(args, CVT_S, l + 1, cw, cn, scr, lane); } }
            if (bx < NG7) {
            LAS int* tile_e = (LAS int*)(lds + TILE_OFF); LAS int* tile_mt = tile_e + 128; LAS int* lcnt = tile_e + 256;
            LAS unsigned* gtab = (LAS unsigned*)(lds + GTAB_OFF); LAS float* wtab = (LAS float*)(lds + LTAB_OFF); LAS float* rtab = (LAS float*)(lds + RTAB_OFF);
            const int* tok = (const int*)(ws + WS_TOK); const float* wgt = (const float*)(ws + WS_WGT); const float* rsl = (const float*)(ws + WS_RSL);
            for (int idx = tid; idx < 4 * 256; idx += 512) {
                const int ui = idx >> 8, rr = idx & 255; unsigned off = 0u;
                const int tp = (ntiles + 7) >> 3, th = 4 * tp, t = ui * (NG7 >> 3) + (bx >> 3), tile = (bx & 7) * tp + (t >> 2);
                float wv = 0.f, rv = 0.f;
                if (t < th && tile < ntiles) { const int e = tile_e[tile], pos = tile_mt[tile] * 256 + rr; if (pos < lcnt[e]) { const int li = slot_index(tile_e + 320, e, pos); off = (unsigned)(tok[li] >> 1) * (unsigned)(D * 2); rv = rsl[li]; wv = wgt[li] * rv; } }
                gtab[idx] = off; wtab[idx] = wv; rtab[idx] = rv;
            }
            __syncthreads();
            SchedMoe S; S.tile_e = tile_e; S.tile_mt = tile_mt; S.gtab = gtab; S.ntiles = ntiles; S.nN = 4; S.G = NG7; S.c = bx;
            S.A = (const char*)(ws + WS_XRES); S.Bt = (const char*)(wl + WL_GU); S.a_tstep = 0; S.b_estep = (size_t)1024 * D * 2; S.b_tstep = (size_t)256 * D * 2; S.gather = true;
            EpiMoeGU E{(bf16*)(ws + WS_ACT), wtab, rtab};
            REP(6, true) pg8::gemm_phase<EpiMoeGU, SchedMoe, true, true>(lds, D, S, E);
            }
            if (MK_STRETCH_ROLE) stretch_ok = (MK_STRETCH_ROLE == 1) == (bx < NG7);
            if (BOTH(pb + 5)) GRID_BAR_P(pb + 5); else STRETCH(pb + 5);
            stretch_ok = true;
        }
        if (PHON(7) && IN(pb + 6)) {
            PHASE_IDS();
            const int ntiles = (MK_N_LAUNCHES == 1) ? ((LAS int*)(lds + TILE_OFF))[288] : moe_tables(args, l, lds, tid);
            const int NG8 = (l + 1 < DEPTH && (ntiles * 8 + 223) / 224 == (ntiles * 8 + 255) / 256) ? 224 : 256;
            if (bx >= NG8 && l + 1 < DEPTH) cvt_run(args, CVT_S, l + 1, (bx - NG8) * NWAVES + wave, (256 - NG8) * NWAVES, (LAS float*)(lds + wave * 16384), lane);
            if (bx < NG8) {
            LAS int* tile_e = (LAS int*)(lds + TILE_OFF); LAS int* tile_mt = tile_e + 128; LAS int* lcnt = tile_e + 256;
            LAS int* ltab = (LAS int*)(lds + LTAB_OFF); const int* tokp = (const int*)(ws + WS_TOK);
            for (int idx = tid; idx < 4 * 256; idx += 512) {
                const int ui = idx >> 8, rr = idx & 255, L = ui * NG8 + bx; int li = -1;
                if (L < ntiles * 8) { const int tile = L >> 3, e = tile_e[tile], pos = tile_mt[tile] * 256 + rr; if (pos < lcnt[e]) li = tokp[slot_index(tile_e + 320, e, pos)]; }
                ltab[idx] = li;
            }
            __syncthreads();
            SchedMoe S; S.tile_e = tile_e; S.tile_mt = tile_mt; S.gtab = (LAS unsigned*)(lds + GTAB_OFF); S.ntiles = ntiles; S.nN = 8; S.G = NG8; S.c = bx;
            S.A = (const char*)(ws + WS_ACT); S.Bt = (const char*)(wl + WL_D); S.a_tstep = (size_t)256 * FF * 2; S.b_estep = (size_t)D * FF * 2; S.b_tstep = (size_t)256 * FF * 2; S.gather = false;
            EpiMoeDown E{(bf16*)(ws + WS_Y2), (const int*)(ws + WS_TOK), ltab};
            REP(7, true) pg8::gemm_phase<EpiMoeDown, SchedMoe, true, false>(lds, FF, S, E);
            }
            if (BOTH(pb + 6)) GRID_BAR_P(pb + 6); else STRETCH(pb + 6);
        }
        if (PHON(8) && IN(pb + 7)) {
            PHASE_IDS();
            const int gw = vcu * NWAVES + wave, NGW = G * NWAVES;
            bf16* X = (bf16*)(ws + WS_XRES); const bf16* Y2 = (const bf16*)(ws + WS_Y2);
            REP(8, l + 1 == DEPTH) for (int m = gw; m < M; m += NGW) {
                if (l + 1 < DEPTH) norm_row(nullptr, Y2 + (size_t)(2 * m) * D, Y2 + (size_t)(2 * m + 1) * D, X + (size_t)m * D, args.in[1] + (size_t)(l + 1) * D, (bf16*)(ws + WS_H) + (size_t)m * D, nullptr, lane, ws + WS_H8 + (size_t)m * D, X + (size_t)m * D);
                else norm_row(nullptr, Y2 + (size_t)(2 * m) * D, Y2 + (size_t)(2 * m + 1) * D, nullptr, args.in[16], nullptr, args.out + (size_t)m * D, lane, nullptr, X + (size_t)m * D);
            }
            if (BOTH(pb + 7)) GRID_BAR_P(pb + 7); else STRETCH(pb + 7);
        }
    }
#undef IN
#undef BOTH
}

extern "C" void kernel_launch(void* const* d_in, const int* in_sizes, int n_in, void* d_out, int out_size, void* d_ws, size_t ws_size, hipStream_t stream) {
    static int grid = 0;
    if (grid == 0) {
        if (n_in != 17 || in_sizes[0] != M * D || out_size != M * D || ws_size < WS_END) { fprintf(stderr, "kernel_launch: unexpected shapes (n_in %d, in0 %d, out %d, ws %zu)\n", n_in, n_in > 0 ? in_sizes[0] : -1, out_size, ws_size); grid = -1; return; }
        int dev = 0, cus = 0, per_cu = 0;
        if (hipGetDevice(&dev) != hipSuccess || hipDeviceGetAttribute(&cus, hipDeviceAttributeMultiprocessorCount, dev) != hipSuccess) { grid = -1; return; }
        if (hipFuncSetAttribute((const void*)mk_fwd, hipFuncAttributeMaxDynamicSharedMemorySize, LDS_BYTES) != hipSuccess) { fprintf(stderr, "kernel_launch: hipFuncSetAttribute failed\n"); grid = -1; return; }
        if (hipOccupancyMaxActiveBlocksPerMultiprocessor(&per_cu, (const void*)mk_fwd, NWAVES * 64, LDS_BYTES) != hipSuccess || per_cu < 1)
            fprintf(stderr, "kernel_launch: occupancy query reports %d workgroups per CU\n", per_cu);
        (void)hipGetLastError();
        if (cus != 256) { fprintf(stderr, "kernel_launch: built for a 256-CU device (got %d CUs); nothing launched\n", cus); grid = -1; return; }
        grid = cus;
    }
    if (grid < 0) return;
    if (hipMemsetAsync((char*)d_ws + WS_CTL, 0, CTL_ZERO_BYTES, stream) != hipSuccess) return;
    Args a{};
    for (int i = 0; i < 17; ++i) a.in[i] = (const float*)d_in[i];
    a.out = (float*)d_out; a.ws = (unsigned char*)d_ws;
    if (MK_N_LAUNCHES == 1) {
        a.ph_lo = 0; a.ph_hi = NPHASE; a.li = 0;
        hipLaunchKernelGGL(mk_fwd, dim3(grid), dim3(NWAVES * 64), LDS_BYTES, stream, a);
    } else {
        for (int p = 0; p < MK_PH_END; ++p) { a.ph_lo = p; a.ph_hi = p + 1; a.li = p; hipLaunchKernelGGL(mk_fwd, dim3(grid), dim3(NWAVES * 64), LDS_BYTES, stream, a); }
    }
    const hipError_t le = hipPeekAtLastError();
    if (le != hipSuccess) fprintf(stderr, "kernel_launch: launch failed: %s\n", hipGetErrorName(le));
}
```
